# Optimizing an MI355X kernel written in HIP

```python
import jax, jax.numpy as jnp
from jax import lax
import numpy as np

D_MODEL = 2048
BATCH = 4
SEQ = 2048
DEPTH = 1

N_HEADS = 16
HEAD_DIM = D_MODEL // N_HEADS
ATTN_WIDTH = N_HEADS * HEAD_DIM
CONV_WIDTH = D_MODEL
CONV_KERNEL = 3
MOBA_BLOCK = 256
MOBA_TOPK = 3
Q_CHUNK = 16
D_FF = ((8 * D_MODEL // 3 + 255) // 256) * 256
RMS_EPS = 1e-6
IN_WIDTH = 3 * ATTN_WIDTH + 3 * CONV_WIDTH + 2 * D_MODEL

kernel_name = 'macaron_hybrid_moba_shortconv_alibi'


def rms_norm(x, g):
    xf = x.astype(jnp.float32)
    y = xf * lax.rsqrt(jnp.mean(xf * xf, axis=-1, keepdims=True) + RMS_EPS)
    return (y * g.astype(jnp.float32)).astype(x.dtype)


def swiglu(h, w_gate, w_up, w_down):
    return (jax.nn.silu(h @ w_gate) * (h @ w_up)) @ w_down


def alibi_slopes():
    return jnp.exp2(-8.0 * jnp.arange(1, N_HEADS + 1, dtype=jnp.float32) / N_HEADS)


def moba_attention(q, k, v):
    bsz, s, h, hd = q.shape
    nb = -(-s // MOBA_BLOCK)
    s_pad = nb * MOBA_BLOCK
    pad = ((0, 0), (0, s_pad - s), (0, 0), (0, 0))
    q, k, v = [jnp.pad(a, pad).transpose(0, 2, 1, 3) for a in (q, k, v)]
    kb = k.reshape(bsz, h, nb, MOBA_BLOCK, hd)
    vb = v.reshape(bsz, h, nb, MOBA_BLOCK, hd)
    slopes = alibi_slopes()
    scale = HEAD_DIM ** -0.5

    kmean = jnp.mean(kb.astype(jnp.float32), axis=3)
    gate = jnp.einsum('bhqd,bhnd->bhqn', q.astype(jnp.float32), kmean)
    qblk = jnp.arange(s_pad) // MOBA_BLOCK
    past = jnp.arange(nb)[None, :] < qblk[:, None]
    gate = jnp.where(past, gate, -jnp.inf)
    n_sel = min(MOBA_TOPK, nb)
    _, sel = lax.top_k(gate, n_sel)

    n_chunks = s_pad // Q_CHUNK
    q_chunks = jnp.moveaxis(q.reshape(bsz, h, n_chunks, Q_CHUNK, hd), 2, 0)
    sel_chunks = jnp.moveaxis(sel.reshape(bsz, h, n_chunks, Q_CHUNK, n_sel), 2, 0)
    starts = jnp.arange(n_chunks, dtype=jnp.int32) * Q_CHUNK
    bi = jnp.arange(bsz)[:, None, None, None]
    hi = jnp.arange(h)[None, :, None, None]
    offs = jnp.arange(MOBA_BLOCK)

    def one_chunk(args):
        qc, selc, start = args
        tq = start + jnp.arange(Q_CHUNK)
        own = start // MOBA_BLOCK
        kg = kb[bi, hi, selc]
        vg = vb[bi, hi, selc]
        ko = lax.dynamic_index_in_dim(kb, own, axis=2, keepdims=False)
        vo = lax.dynamic_index_in_dim(vb, own, axis=2, keepdims=False)
        kpos_sel = selc[..., None] * MOBA_BLOCK + offs
        dist_sel = (tq[:, None, None] - kpos_sel).astype(jnp.float32)
        s_sel = jnp.einsum('bhqd,bhqnjd->bhqnj', qc, kg,
                           preferred_element_type=jnp.float32) * scale
        s_sel = s_sel - slopes[:, None, None, None] * dist_sel
        s_sel = jnp.where((selc < own)[..., None], s_sel, -jnp.inf)
        kpos_own = own * MOBA_BLOCK + offs
        dist_own = (tq[:, None] - kpos_own[None, :]).astype(jnp.float32)
        s_own = jnp.einsum('bhqd,bhjd->bhqj', qc, ko,
                           preferred_element_type=jnp.float32) * scale
        s_own = s_own - slopes[:, None, None] * dist_own
        s_own = jnp.where(dist_own >= 0, s_own, -jnp.inf)
        scores = jnp.concatenate(
            [s_sel.reshape(bsz, h, Q_CHUNK, n_sel * MOBA_BLOCK), s_own], axis=-1)
        p = jax.nn.softmax(scores, axis=-1).astype(vg.dtype)
        p_sel = p[..., :n_sel * MOBA_BLOCK].reshape(bsz, h, Q_CHUNK, n_sel, MOBA_BLOCK)
        p_own = p[..., n_sel * MOBA_BLOCK:]
        return (jnp.einsum('bhqnj,bhqnjd->bhqd', p_sel, vg)
                + jnp.einsum('bhqj,bhjd->bhqd', p_own, vo))

    out = lax.map(one_chunk, (q_chunks, sel_chunks, starts))
    out = jnp.moveaxis(out, 0, 2).reshape(bsz, h, s_pad, hd)
    out = out.transpose(0, 2, 1, 3)[:, :s]
    return out.reshape(bsz, s, h * hd)


def short_conv(u, conv_w):
    rhs = conv_w[:, None, :]
    return lax.conv_general_dilated(
        u, rhs, window_strides=(1,), padding=[(CONV_KERNEL - 1, 0)],
        dimension_numbers=('NWC', 'WIO', 'NWC'), feature_group_count=u.shape[-1])


def hybrid_mixer(h, w_in, b_gate, conv_w, w_attn_out, w_conv_out, w_out):
    bsz, s, _ = h.shape
    z = h @ w_in
    cuts = np.cumsum([ATTN_WIDTH] * 3 + [CONV_WIDTH] * 3).tolist()
    q, k, v, gb, gc, xt, g_logits = jnp.split(z, cuts, axis=-1)
    g_logits = (g_logits + b_gate).astype(jnp.float32)
    g_attn = jax.nn.sigmoid(g_logits[..., :D_MODEL]).astype(h.dtype)
    g_conv = jax.nn.sigmoid(g_logits[..., D_MODEL:]).astype(h.dtype)
    shp = (bsz, s, N_HEADS, HEAD_DIM)
    y_attn = moba_attention(q.reshape(shp), k.reshape(shp), v.reshape(shp)) @ w_attn_out
    y_conv = (gb * short_conv(gc * xt, conv_w)) @ w_conv_out
    return (g_attn * y_attn + g_conv * y_conv) @ w_out


def setup_inputs(seed: int = 0) -> dict:
    key = jax.random.key(seed)
    ks = jax.random.split(key, 20)

    def nrm(k, shape, fan_in):
        return jax.random.normal(k, shape, jnp.float32) * (fan_in ** -0.5)

    def gain(k):
        return 1.0 + 0.01 * jax.random.normal(k, (DEPTH, D_MODEL), jnp.float32)

    return {
        'x': jax.random.normal(ks[0], (BATCH, SEQ, D_MODEL), jnp.float32),
        'ffn1_norm': gain(ks[1]),
        'ffn1_w_gate': nrm(ks[2], (DEPTH, D_MODEL, D_FF), D_MODEL),
        'ffn1_w_up': nrm(ks[3], (DEPTH, D_MODEL, D_FF), D_MODEL),
        'ffn1_w_down': nrm(ks[4], (DEPTH, D_FF, D_MODEL), D_FF),
        'mix_norm': gain(ks[5]),
        'w_in': nrm(ks[6], (DEPTH, D_MODEL, IN_WIDTH), D_MODEL),
        'b_gate': 0.01 * jax.random.normal(ks[7], (DEPTH, 2 * D_MODEL), jnp.float32),
        'conv_w': nrm(ks[8], (DEPTH, CONV_KERNEL, CONV_WIDTH), CONV_KERNEL),
        'w_attn_out': nrm(ks[9], (DEPTH, ATTN_WIDTH, D_MODEL), ATTN_WIDTH),
        'w_conv_out': nrm(ks[10], (DEPTH, CONV_WIDTH, D_MODEL), CONV_WIDTH),
        'w_out': nrm(ks[11], (DEPTH, D_MODEL, D_MODEL), D_MODEL),
        'ffn2_norm': gain(ks[12]),
        'ffn2_w_gate': nrm(ks[13], (DEPTH, D_MODEL, D_FF), D_MODEL),
        'ffn2_w_up': nrm(ks[14], (DEPTH, D_MODEL, D_FF), D_MODEL),
        'ffn2_w_down': nrm(ks[15], (DEPTH, D_FF, D_MODEL), D_FF),
        'final_norm': 1.0 + 0.01 * jax.random.normal(ks[16], (D_MODEL,), jnp.float32),
    }


def reference(x, ffn1_norm, ffn1_w_gate, ffn1_w_up, ffn1_w_down, mix_norm, w_in, b_gate,
              conv_w, w_attn_out, w_conv_out, w_out, ffn2_norm, ffn2_w_gate, ffn2_w_up,
              ffn2_w_down, final_norm):
    for l in range(DEPTH):
        x = x + 0.5 * swiglu(rms_norm(x, ffn1_norm[l]), ffn1_w_gate[l], ffn1_w_up[l], ffn1_w_down[l])
        x = x + hybrid_mixer(rms_norm(x, mix_norm[l]), w_in[l], b_gate[l], conv_w[l],
                             w_attn_out[l], w_conv_out[l], w_out[l])
        x = x + 0.5 * swiglu(rms_norm(x, ffn2_norm[l]), ffn2_w_gate[l], ffn2_w_up[l], ffn2_w_down[l])
    return rms_norm(x, final_norm)
```

```cpp
#include <hip/hip_runtime.h>
#include <cstdio>
#include <cstdint>

typedef unsigned short bf16_t;
typedef short bf16x8 __attribute__((ext_vector_type(8)));
typedef float f32x4 __attribute__((ext_vector_type(4)));

constexpr int NB = 4, S = 2048, D = 2048, NH = 16, HD = 128, FF = 5632, M = NB * S, INW = 16384;
constexpr float EPS = 1e-6f;
constexpr size_t MiB = 1u << 20;
constexpr size_t WS_CTL = 0;
constexpr size_t WS_W1 = 1 * MiB;
constexpr size_t WS_W2 = WS_W1 + 44 * MiB;
constexpr size_t WS_WIN = WS_W2 + 22 * MiB;
constexpr size_t WS_WA = WS_WIN + 64 * MiB;
constexpr size_t WS_WC = WS_WA + 8 * MiB;
constexpr size_t WS_WO = WS_WC + 8 * MiB;
constexpr size_t WS_W3 = WS_WO + 8 * MiB;
constexpr size_t WS_W4 = WS_W3 + 44 * MiB;
constexpr size_t WS_XB = WS_W4 + 22 * MiB;
constexpr size_t WS_Z = WS_XB + 32 * MiB;
constexpr size_t WS_Q = WS_Z, WS_K = WS_Z + 32 * MiB, WS_V = WS_Z + 64 * MiB, WS_GB = WS_Z + 96 * MiB, WS_U = WS_Z + 128 * MiB,
                 WS_GA = WS_Z + 160 * MiB, WS_GC = WS_Z + 192 * MiB;
constexpr size_t WS_H = WS_Z;
constexpr size_t WS_O = WS_Q;
constexpr size_t WS_END = WS_Z + 224 * MiB;
constexpr int C_RSTD1 = 0, C_RSTD2 = 8192, C_RSTD3 = 16384, C_RSTD4 = 24576, C_KMEAN = 32768;

__device__ __forceinline__ unsigned f2bf(float f) { unsigned u = __builtin_bit_cast(unsigned, f); return (u + 0x7fffu + ((u >> 16) & 1u)) >> 16; }
__device__ __forceinline__ float bf2f(bf16_t b) { return __builtin_bit_cast(float, (unsigned)b << 16); }

__global__ __launch_bounds__(256) void convert_w(const float* __restrict__ W, const float* __restrict__ W2, const float* __restrict__ g, bf16_t* __restrict__ out, int K, int Nsrc, int Nout, int mode) {
    __shared__ float tile[32][33];
    const int n0 = blockIdx.x * 32, k0 = blockIdx.y * 32, tx = threadIdx.x & 31, ty = threadIdx.x >> 5;
    const float* src = W; int sc = n0;
    if (mode == 1) { const int j = n0 >> 8, c = n0 & 255; if (c < 128) { src = W; sc = 128 * j + c; } else { src = W2; sc = 128 * j + c - 128; } }
    else if (mode == 2) { if (n0 >= 8192 && n0 < 12288) { const int t = n0 - 8192, j = t >> 8, c = t & 255; sc = c < 128 ? 8192 + 128 * j + c : 10240 + 128 * j + (c - 128); } }
    for (int i = ty; i < 32; i += 8) { const int k = k0 + i; float v = src[(size_t)k * Nsrc + sc + tx]; if (g) v *= g[k]; tile[i][tx] = v; }
    __syncthreads();
    for (int i = ty; i < 32; i += 8) out[(size_t)(n0 + i) * K + k0 + tx] = (bf16_t)f2bf(tile[tx][i]);
}

__global__ __launch_bounds__(256) void prep_rows(const float* __restrict__ X, bf16_t* __restrict__ XB, float* __restrict__ rstd) {
    const int row = blockIdx.x * 4 + (threadIdx.x >> 6), lane = threadIdx.x & 63;
    const float* xr = X + (size_t)row * D; float s = 0.f;
    for (int j = 0; j < 8; ++j) { const f32x4 v = *(const f32x4*)(xr + j * 256 + lane * 4); s += v[0] * v[0] + v[1] * v[1] + v[2] * v[2] + v[3] * v[3];
        if (XB) { unsigned long long w = (unsigned long long)(f2bf(v[0]) | (f2bf(v[1]) << 16)) | ((unsigned long long)(f2bf(v[2]) | (f2bf(v[3]) << 16)) << 32); *(unsigned long long*)(XB + (size_t)row * D + j * 256 + lane * 4) = w; } }
    for (int o = 1; o < 64; o <<= 1) s += __shfl_xor(s, o);
    if (lane == 0) rstd[row] = 1.0f / sqrtf(s * (1.0f / D) + EPS);
}
__global__ __launch_bounds__(256) void final_norm(float* __restrict__ X, const float* __restrict__ rstd, const float* __restrict__ g) {
    const int row = blockIdx.x * 4 + (threadIdx.x >> 6), lane = threadIdx.x & 63; const float r = rstd[row];
    float* xr = X + (size_t)row * D;
    for (int j = 0; j < 8; ++j) { f32x4 v = *(f32x4*)(xr + j * 256 + lane * 4); const f32x4 gg = *(const f32x4*)(g + j * 256 + lane * 4); v = v * r * gg; *(f32x4*)(xr + j * 256 + lane * 4) = v; }
}

template <bool DUAL, class Epi>
__global__ __launch_bounds__(256) void sgemm(const bf16_t* __restrict__ A, const bf16_t* __restrict__ Bt, int K, Epi epi) {
    const int lane = threadIdx.x & 63, w = threadIdx.x >> 6, fr = lane & 15, fq = lane >> 4;
    const int row0 = blockIdx.y * 64 + w * 16;
    f32x4 acc[4]; for (int t = 0; t < 4; ++t) acc[t] = (f32x4){0.f, 0.f, 0.f, 0.f};
    const bf16_t* ap = A + (size_t)(row0 + fr) * K + fq * 8;
    const bf16_t* bp[4]; int col0;
    if (!DUAL) { col0 = blockIdx.x * 64; for (int t = 0; t < 4; ++t) bp[t] = Bt + (size_t)(col0 + 16 * t + fr) * K + fq * 8; }
    else { col0 = blockIdx.x * 32; for (int t = 0; t < 2; ++t) { const int j = col0 + 16 * t + fr; const int grow = 256 * (j >> 7) + (j & 127); bp[t] = Bt + (size_t)grow * K + fq * 8; bp[t + 2] = bp[t] + (size_t)128 * K; } }
    for (int k0 = 0; k0 < K; k0 += 32) {
        const bf16x8 a = *(const bf16x8*)(ap + k0);
#pragma unroll
        for (int t = 0; t < 4; ++t) { const bf16x8 b = *(const bf16x8*)(bp[t] + k0); acc[t] = __builtin_amdgcn_mfma_f32_16x16x32_bf16(a, b, acc[t], 0, 0, 0); }
    }
    if (!DUAL) { for (int t = 0; t < 4; ++t) for (int j = 0; j < 4; ++j) epi(row0 + fq * 4 + j, col0 + 16 * t + fr, acc[t][j], 0.f); }
    else { for (int t = 0; t < 2; ++t) for (int j = 0; j < 4; ++j) epi(row0 + fq * 4 + j, col0 + 16 * t + fr, acc[t][j], acc[t + 2][j]); }
}

struct EpiSwiglu { bf16_t* H; const float* rstd;
    __device__ void operator()(int row, int col, float g, float u) const { const float r = rstd[row]; g *= r; u *= r; const float s = g / (1.f + __expf(-g)); H[(size_t)row * FF + col] = (bf16_t)f2bf(s * u); } };
struct EpiResid { float* X; bf16_t* XB; float scale; int pad;
    __device__ void operator()(int row, int col, float v, float) const { const size_t i = (size_t)row * D + col; const float x = X[i] + scale * v; X[i] = x; XB[i] = (bf16_t)f2bf(x); } };
struct EpiResid0 { const float* X0; float* X; bf16_t* XB; float scale; int pad;
    __device__ void operator()(int row, int col, float v, float) const { const size_t i = (size_t)row * D + col; const float x = X0[i] + scale * v; X[i] = x; XB[i] = (bf16_t)f2bf(x); } };
struct EpiQKV { bf16_t* Q; const float* rstd;
    __device__ void operator()(int row, int col, float v, float) const { const int t = col >> 11, c = col & 2047, h = c >> 7, d = c & 127, b = row >> 11, s = row & 2047;
        Q[(size_t)t * (32 * MiB / 2) + ((size_t)((b * NH + h) * S + s)) * HD + d] = (bf16_t)f2bf(v * rstd[row]); } };
struct EpiPlain { bf16_t* O; const float* rstd;
    __device__ void operator()(int row, int col, float v, float) const { O[(size_t)row * D + col] = (bf16_t)f2bf(v * rstd[row]); } };
struct EpiMul { bf16_t* O; const float* rstd;
    __device__ void operator()(int row, int col, float g, float u) const { const float r = rstd[row]; O[(size_t)row * D + col] = (bf16_t)f2bf((g * r) * (u * r)); } };
struct EpiGate { bf16_t* GA; const float* rstd; const float* bias;
    __device__ void operator()(int row, int col, float v, float) const { const float z = v * rstd[row] + bias[col]; const float sg = 1.f / (1.f + __expf(-z)); const int t = col >> 11, c = col & 2047;
        GA[(size_t)t * (32 * MiB / 2) + (size_t)row * D + c] = (bf16_t)f2bf(sg); } };
struct EpiT { float* T; const bf16_t* G;
    __device__ void operator()(int row, int col, float v, float) const { const size_t i = (size_t)row * D + col; T[i] = bf2f(G[i]) * v; } };
struct EpiM { bf16_t* Mo; const float* T; const bf16_t* G;
    __device__ void operator()(int row, int col, float v, float) const { const size_t i = (size_t)row * D + col; Mo[i] = (bf16_t)f2bf(bf2f(G[i]) * v + T[i]); } };

__global__ __launch_bounds__(128) void kmean_k(const bf16_t* __restrict__ Kb, float* __restrict__ km) {
    const int bh = blockIdx.x >> 3, blk = blockIdx.x & 7, d = threadIdx.x, b = bh >> 4, h = bh & 15;
    const bf16_t* kp = Kb + ((size_t)bh * S + blk * 256) * HD + d; float s = 0.f;
    for (int r = 0; r < 256; ++r) s += bf2f(kp[(size_t)r * HD]);
    km[(size_t)(b * 8 + blk) * D + h * HD + d] = s * (1.f / 256.f);
}

__global__ __launch_bounds__(256) void attn_simple(const bf16_t* __restrict__ Q, const bf16_t* __restrict__ Kb, const bf16_t* __restrict__ Vb, const float* __restrict__ km, bf16_t* __restrict__ O) {
    __shared__ float q_s[128], gate_s[8], p_s[1024], red_s[8], acc_s[128];
    __shared__ int blk_s[4], cnt_s;
    const int tid = threadIdx.x, lane = tid & 63, w = tid >> 6;
    const int bh = blockIdx.x >> 11, s = blockIdx.x & 2047, b = bh >> 4, h = bh & 15, own = s >> 8;
    const float slope = exp2f(-0.5f * (float)(h + 1)), scale = 0.08838834764831845f;
    if (tid < 128) q_s[tid] = bf2f(Q[((size_t)bh * S + s) * HD + tid]);
    __syncthreads();
    for (int j = w; j < own; j += 4) { const float* kmp = km + (size_t)(b * 8 + j) * D + h * HD; float p = q_s[lane] * kmp[lane] + q_s[lane + 64] * kmp[lane + 64];
        for (int o = 1; o < 64; o <<= 1) p += __shfl_xor(p, o);
        if (lane == 0) gate_s[j] = p; }
    __syncthreads();
    if (tid == 0) { unsigned mask = 0; if (own <= 3) mask = (1u << own) - 1u; else { for (int it = 0; it < 3; ++it) { int best = -1; float bv = 0.f; for (int j = 0; j < own; ++j) if (!((mask >> j) & 1u) && (best < 0 || gate_s[j] > bv)) { best = j; bv = gate_s[j]; } mask |= 1u << best; } }
        int c = 0; for (int j = 0; j < own; ++j) if ((mask >> j) & 1u) blk_s[c++] = j; blk_s[c++] = own; cnt_s = c; }
    __syncthreads();
    const int cnt = cnt_s; float mx = -INFINITY;
    for (int c = 0; c < cnt; ++c) { const int j = blk_s[c], pos = j * 256 + tid; const bf16_t* kp = Kb + ((size_t)bh * S + pos) * HD; float dot = 0.f;
        for (int d8 = 0; d8 < 16; ++d8) { const bf16x8 kv = *(const bf16x8*)(kp + d8 * 8); for (int e = 0; e < 8; ++e) dot += q_s[d8 * 8 + e] * bf2f((bf16_t)kv[e]); }
        float sc = dot * scale - slope * (float)(s - pos); if (pos > s) sc = -INFINITY; p_s[c * 256 + tid] = sc; mx = fmaxf(mx, sc); }
    for (int o = 1; o < 64; o <<= 1) mx = fmaxf(mx, __shfl_xor(mx, o));
    if (lane == 0) red_s[w] = mx;
    __syncthreads();
    mx = fmaxf(fmaxf(red_s[0], red_s[1]), fmaxf(red_s[2], red_s[3]));
    float sum = 0.f;
    for (int c = 0; c < cnt; ++c) { const float p = __expf(p_s[c * 256 + tid] - mx); p_s[c * 256 + tid] = p; sum += p; }
    for (int o = 1; o < 64; o <<= 1) sum += __shfl_xor(sum, o);
    if (lane == 0) red_s[4 + w] = sum;
    __syncthreads();
    const float l = red_s[4] + red_s[5] + red_s[6] + red_s[7];
    const int d = tid & 127, half = tid >> 7, nk = cnt * 256; float acc = 0.f;
    for (int i = half * (nk / 2); i < (half + 1) * (nk / 2); ++i) { const int pos = blk_s[i >> 8] * 256 + (i & 255); acc += p_s[i] * bf2f(Vb[((size_t)bh * S + pos) * HD + d]); }
    if (half == 1) acc_s[d] = acc;
    __syncthreads();
    if (half == 0) O[((size_t)(b * S + s)) * D + h * HD + d] = (bf16_t)f2bf((acc + acc_s[d]) / l);
}

__global__ __launch_bounds__(256) void conv_k(bf16_t* __restrict__ GB, const bf16_t* __restrict__ U, const float* __restrict__ cw) {
    const size_t idx = (size_t)blockIdx.x * 256 + threadIdx.x; const int row = (int)(idx >> 11), ch = (int)(idx & 2047), s = row & 2047;
    float y = cw[2 * D + ch] * bf2f(U[idx]);
    if (s >= 1) y += cw[1 * D + ch] * bf2f(U[idx - D]);
    if (s >= 2) y += cw[0 * D + ch] * bf2f(U[idx - 2 * D]);
    GB[idx] = (bf16_t)f2bf(bf2f(GB[idx]) * y);
}

extern "C" void kernel_launch(void* const* d_in, const int* in_sizes, int n_in, void* d_out, int out_size, void* d_ws, size_t ws_size, hipStream_t stream) {
    if (n_in != 17 || out_size != M * D || ws_size < WS_END + 32 * MiB) { fprintf(stderr, "kernel_launch: unexpected shapes (n_in %d out %d ws %zu)\n", n_in, out_size, ws_size); return; }
    const float* x = (const float*)d_in[0]; const float* g1 = (const float*)d_in[1]; const float* w1g = (const float*)d_in[2]; const float* w1u = (const float*)d_in[3]; const float* w1d = (const float*)d_in[4];
    const float* gm = (const float*)d_in[5]; const float* win = (const float*)d_in[6]; const float* bgate = (const float*)d_in[7]; const float* cw = (const float*)d_in[8];
    const float* wa = (const float*)d_in[9]; const float* wc = (const float*)d_in[10]; const float* wo = (const float*)d_in[11]; const float* g2 = (const float*)d_in[12];
    const float* w2g = (const float*)d_in[13]; const float* w2u = (const float*)d_in[14]; const float* w2d = (const float*)d_in[15]; const float* gf = (const float*)d_in[16];
    char* ws = (char*)d_ws; float* out = (float*)d_out; float* ctl = (float*)(ws + WS_CTL);
    bf16_t* W1 = (bf16_t*)(ws + WS_W1); bf16_t* W2 = (bf16_t*)(ws + WS_W2); bf16_t* WIN = (bf16_t*)(ws + WS_WIN); bf16_t* WA = (bf16_t*)(ws + WS_WA); bf16_t* WC = (bf16_t*)(ws + WS_WC);
    bf16_t* WO = (bf16_t*)(ws + WS_WO); bf16_t* W3 = (bf16_t*)(ws + WS_W3); bf16_t* W4 = (bf16_t*)(ws + WS_W4); bf16_t* XB = (bf16_t*)(ws + WS_XB);
    bf16_t* Qb = (bf16_t*)(ws + WS_Q); bf16_t* Kb = (bf16_t*)(ws + WS_K); bf16_t* Vb = (bf16_t*)(ws + WS_V); bf16_t* GB = (bf16_t*)(ws + WS_GB); bf16_t* U = (bf16_t*)(ws + WS_U);
    bf16_t* GA = (bf16_t*)(ws + WS_GA); bf16_t* GC = (bf16_t*)(ws + WS_GC); bf16_t* H = (bf16_t*)(ws + WS_H);
    bf16_t* Ob = (bf16_t*)(ws + WS_END);
    float* T = (float*)(ws + WS_K);
    bf16_t* Mb = U;
    float* rstd1 = ctl + C_RSTD1; float* rstd2 = ctl + C_RSTD2; float* rstd3 = ctl + C_RSTD3; float* rstd4 = ctl + C_RSTD4; float* km = ctl + C_KMEAN;
    convert_w<<<dim3(11264 / 32, 2048 / 32), 256, 0, stream>>>(w1g, w1u, g1, W1, 2048, FF, 11264, 1);
    convert_w<<<dim3(2048 / 32, FF / 32), 256, 0, stream>>>(w1d, nullptr, nullptr, W2, FF, 2048, 2048, 0);
    convert_w<<<dim3(INW / 32, 2048 / 32), 256, 0, stream>>>(win, nullptr, gm, WIN, 2048, INW, INW, 2);
    convert_w<<<dim3(64, 64), 256, 0, stream>>>(wa, nullptr, nullptr, WA, 2048, 2048, 2048, 0);
    convert_w<<<dim3(64, 64), 256, 0, stream>>>(wc, nullptr, nullptr, WC, 2048, 2048, 2048, 0);
    convert_w<<<dim3(64, 64), 256, 0, stream>>>(wo, nullptr, nullptr, WO, 2048, 2048, 2048, 0);
    convert_w<<<dim3(11264 / 32, 2048 / 32), 256, 0, stream>>>(w2g, w2u, g2, W3, 2048, FF, 11264, 1);
    convert_w<<<dim3(2048 / 32, FF / 32), 256, 0, stream>>>(w2d, nullptr, nullptr, W4, FF, 2048, 2048, 0);
    prep_rows<<<M / 4, 256, 0, stream>>>(x, XB, rstd1);
    sgemm<true, EpiSwiglu><<<dim3(FF / 32, M / 64), 256, 0, stream>>>(XB, W1, 2048, EpiSwiglu{H, rstd1});
    sgemm<false, EpiResid0><<<dim3(D / 64, M / 64), 256, 0, stream>>>(H, W2, FF, EpiResid0{x, out, XB, 0.5f, 0});
    prep_rows<<<M / 4, 256, 0, stream>>>(out, nullptr, rstd2);
    sgemm<false, EpiQKV><<<dim3(6144 / 64, M / 64), 256, 0, stream>>>(XB, WIN, 2048, EpiQKV{Qb, rstd2});
    sgemm<false, EpiPlain><<<dim3(2048 / 64, M / 64), 256, 0, stream>>>(XB, WIN + (size_t)6144 * 2048, 2048, EpiPlain{GB, rstd2});
    sgemm<true, EpiMul><<<dim3(2048 / 32, M / 64), 256, 0, stream>>>(XB, WIN + (size_t)8192 * 2048, 2048, EpiMul{U, rstd2});
    sgemm<false, EpiGate><<<dim3(4096 / 64, M / 64), 256, 0, stream>>>(XB, WIN + (size_t)12288 * 2048, 2048, EpiGate{GA, rstd2, bgate});
    kmean_k<<<NB * NH * 8, 128, 0, stream>>>(Kb, km);
    attn_simple<<<NB * NH * S, 256, 0, stream>>>(Qb, Kb, Vb, km, Ob);
    conv_k<<<M * D / 256, 256, 0, stream>>>(GB, U, cw);
    sgemm<false, EpiT><<<dim3(D / 64, M / 64), 256, 0, stream>>>(GB, WC, 2048, EpiT{T, GC});
    sgemm<false, EpiM><<<dim3(D / 64, M / 64), 256, 0, stream>>>(Ob, WA, 2048, EpiM{Mb, T, GA});
    sgemm<false, EpiResid><<<dim3(D / 64, M / 64), 256, 0, stream>>>(Mb, WO, 2048, EpiResid{out, XB, 1.0f, 0});
    prep_rows<<<M / 4, 256, 0, stream>>>(out, nullptr, rstd3);
    sgemm<true, EpiSwiglu><<<dim3(FF / 32, M / 64), 256, 0, stream>>>(XB, W3, 2048, EpiSwiglu{H, rstd3});
    sgemm<false, EpiResid><<<dim3(D / 64, M / 64), 256, 0, stream>>>(H, W4, FF, EpiResid{out, XB, 0.5f, 0});
    prep_rows<<<M / 4, 256, 0, stream>>>(out, nullptr, rstd4);
    final_norm<<<M / 4, 256, 0, stream>>>(out, rstd4, gf);
}
```

```cpp
#include <hip/hip_runtime.h>
#include <cstdio>
#include <cstdint>


constexpr int NB = 4, S = 2048, D = 2048, NH = 16, HD = 128, FF = 5632, M = NB * S, INW = 16384;
constexpr float EPS = 1e-6f;
#define MK_STAGE 2
namespace pg8 {
#define PG8_LAS __attribute__((address_space(3)))
typedef unsigned short bf16_t;
typedef short bf16x8 __attribute__((ext_vector_type(8)));
typedef float f32x4 __attribute__((ext_vector_type(4)));
typedef unsigned u32x4 __attribute__((ext_vector_type(4)));
typedef unsigned u32x2 __attribute__((ext_vector_type(2)));
constexpr int BM = 256, BK = 64, HALF = 128, HTB = HALF * BK * 2  , STAGE_BYTES = 8 * HTB, NXCD = 8, WGM = 8;

__host__ __device__ __forceinline__ int lds_byte(int r, int c) { const int st = (r >> 4) * 2 + (c >> 5), rr = r & 15, cc = c & 31, ob = rr * 64 + cc * 2; return st * 1024 + (ob ^ (((ob >> 9) & 1) << 5)); }
__host__ __device__ __forceinline__ void stage_rc(int b, int& R, int& C) { const int st = b / 1024, sb = b % 1024, swz = sb ^ (((sb >> 9) & 1) << 5); R = (st >> 1) * 16 + swz / 64; C = (st & 1) * 32 + (swz % 64) / 2; }
__host__ __device__ __forceinline__ int perm32(int rho) { const int n = rho >> 4, i = rho & 15; return 8 * (i >> 2) + 4 * n + (i & 3); }

struct Unit { int pm, pn; };
struct Gemm { const bf16_t* A; const bf16_t* Bt; int M, N, K; const bf16_t* A2; int pn_split; };

struct StaticOrder {
    int nM, nN, nwg, G, c;
    __host__ __device__ void init(int M, int N, int G_, int c_) { nM = M / BM; nN = N / BM; nwg = nM * nN; G = G_; c = c_; }
    __host__ __device__ bool next(int i, Unit& u) const {
        const long L = (long)i * G + c; if (L >= nwg) return false;
        int wgid = (int)L; { const int q = nwg / NXCD, r = nwg % NXCD, xcd = wgid % NXCD, off = wgid / NXCD; wgid = (xcd < r ? xcd * (q + 1) : r * (q + 1) + (xcd - r) * q) + off; }
        const int nig = WGM * nN, gid = wgid / nig, fm = gid * WGM, gsz = (nM - fm) < WGM ? (nM - fm) : WGM;
        u.pm = fm + ((wgid % nig) % gsz); u.pn = (wgid % nig) / gsz; return true;
    }
    __device__ __forceinline__ void a_ready(const Unit&) const {}
    __device__ __forceinline__ void done(const Unit&) const {}
};
struct PairOrder {
    StaticOrder so;
    __device__ bool next(int i, Unit& u) const { if (!so.next(i >> 1, u)) return false; if ((i & 1) == 0) u.pn += 8; return true; }
    __device__ __forceinline__ void a_ready(const Unit&) const {}
    __device__ __forceinline__ void done(const Unit&) const {}
};
__device__ __forceinline__ unsigned cvt_pk_bf16(float lo, float hi) { unsigned r; asm volatile("v_cvt_pk_bf16_f32 %0, %1, %2" : "=v"(r) : "v"(lo), "v"(hi)); return r; }
__device__ __forceinline__ float rstd_of(const float* ss, int row) { return __builtin_amdgcn_rsqf(ss[row] * (1.0f / D) + EPS); }
__device__ __forceinline__ f32x4 sigmoid4(f32x4 z) { f32x4 o;
#pragma unroll
    for (int e = 0; e < 4; ++e) o[e] = __builtin_amdgcn_rcpf(1.0f + __builtin_amdgcn_exp2f(-1.4426950408889634f * z[e]));
    return o; }
__device__ __forceinline__ u32x4 pack8(f32x4 a, f32x4 b) { u32x4 w; w.x = cvt_pk_bf16(a[0], a[1]); w.y = cvt_pk_bf16(a[2], a[3]); w.z = cvt_pk_bf16(b[0], b[1]); w.w = cvt_pk_bf16(b[2], b[3]); return w; }
__device__ __forceinline__ void unpack8(u32x4 w, f32x4& a, f32x4& b) {
    a[0] = __builtin_bit_cast(float, w.x << 16); a[1] = __builtin_bit_cast(float, w.x & 0xffff0000u); a[2] = __builtin_bit_cast(float, w.y << 16); a[3] = __builtin_bit_cast(float, w.y & 0xffff0000u);
    b[0] = __builtin_bit_cast(float, w.z << 16); b[1] = __builtin_bit_cast(float, w.z & 0xffff0000u); b[2] = __builtin_bit_cast(float, w.w << 16); b[3] = __builtin_bit_cast(float, w.w & 0xffff0000u); }

struct EpiSwiglu {
    static constexpr bool PERM = true, AFTER_DRAIN = false;
    bf16_t* H; const float* ss;
    __device__ __forceinline__ void operator()(const f32x4 (&acc)[2][2][4][2], const Unit& u, int wr, int wc, int fr, int fq) const {
        const int row0 = u.pm * BM + wr * 64 + fr, col0 = u.pn * HALF + wc * 32 + 8 * fq;
#pragma unroll
        for (int ai = 0; ai < 2; ++ai)
#pragma unroll
            for (int m = 0; m < 4; ++m) { const int row = row0 + ai * HALF + m * 16; const float r = rstd_of(ss, row);
                const f32x4 g0 = acc[ai][0][m][0] * r, g1 = acc[ai][0][m][1] * r, u0 = acc[ai][1][m][0] * r, u1 = acc[ai][1][m][1] * r;
                const f32x4 h0 = g0 * sigmoid4(g0) * u0, h1 = g1 * sigmoid4(g1) * u1;
                *(u32x4*)(H + (size_t)row * FF + col0) = pack8(h0, h1); }
    }
};
struct EpiResid {
    static constexpr bool PERM = true, AFTER_DRAIN = false;
    const float* X0; float* X; bf16_t* XB; float* ss; float scale; int pad;
    __device__ __forceinline__ void operator()(const f32x4 (&acc)[2][2][4][2], const Unit& u, int wr, int wc, int fr, int fq) const {
        const int row0 = u.pm * BM + wr * 64 + fr, col0 = u.pn * BM + wc * 32 + 8 * fq;
#pragma unroll
        for (int ai = 0; ai < 2; ++ai)
#pragma unroll
            for (int m = 0; m < 4; ++m) { const int row = row0 + ai * HALF + m * 16; float sq = 0.f;
#pragma unroll
                for (int bj = 0; bj < 2; ++bj) { const size_t off = (size_t)row * D + col0 + bj * HALF;
                    const f32x4 a = *(const f32x4*)(X0 + off) + acc[ai][bj][m][0] * scale, b = *(const f32x4*)(X0 + off + 4) + acc[ai][bj][m][1] * scale;
                    *(f32x4*)(X + off) = a; *(f32x4*)(X + off + 4) = b;
                    if (XB) *(u32x4*)(XB + off) = pack8(a, b);
                    sq += (a[0] * a[0] + a[1] * a[1]) + (a[2] * a[2] + a[3] * a[3]) + (b[0] * b[0] + b[1] * b[1]) + (b[2] * b[2] + b[3] * b[3]); }
                sq += __shfl_xor(sq, 16); sq += __shfl_xor(sq, 32);
                if (fq == 0) atomicAdd(ss + row, sq); }
    }
};
struct EpiIn {
    static constexpr bool PERM = true, AFTER_DRAIN = false;
    bf16_t* QKV; bf16_t* GB; bf16_t* U; bf16_t* GA; const float* ss; const float* bias; float* kpart;
    __device__ __forceinline__ void operator()(const f32x4 (&acc)[2][2][4][2], const Unit& u, int wr, int wc, int fr, int fq) const {
        const int row0 = u.pm * BM + wr * 64 + fr, cw = wc * 32 + 8 * fq; const int pn = u.pn;
        if (pn < 24) {
            const int t = pn >> 3, hb = 2 * (pn & 7); bf16_t* base = QKV + (size_t)t * ((size_t)M * D);
            const bool isk = (t == 1); f32x4 cs[2][2];
#pragma unroll
            for (int bj = 0; bj < 2; ++bj) { cs[bj][0] = (f32x4){0.f, 0.f, 0.f, 0.f}; cs[bj][1] = (f32x4){0.f, 0.f, 0.f, 0.f}; }
#pragma unroll
            for (int ai = 0; ai < 2; ++ai)
#pragma unroll
                for (int m = 0; m < 4; ++m) { const int row = row0 + ai * HALF + m * 16; const float r = rstd_of(ss, row); const int b = row >> 11, s = row & 2047;
#pragma unroll
                    for (int bj = 0; bj < 2; ++bj) { const f32x4 a = acc[ai][bj][m][0] * r, c = acc[ai][bj][m][1] * r;
                        *(u32x4*)(base + ((size_t)((b * NH + hb + bj) * S + s)) * HD + cw) = pack8(a, c);
                        if (isk) { cs[bj][0] += a; cs[bj][1] += c; } } }
            if (isk) {
#pragma unroll
                for (int bj = 0; bj < 2; ++bj)
#pragma unroll
                    for (int n = 0; n < 2; ++n)
#pragma unroll
                        for (int e = 0; e < 4; ++e) { float v = cs[bj][n][e]; v += __shfl_xor(v, 1); v += __shfl_xor(v, 2); v += __shfl_xor(v, 4); v += __shfl_xor(v, 8); cs[bj][n][e] = v; }
                if (fr == 0) {
#pragma unroll
                    for (int bj = 0; bj < 2; ++bj) { float* kp = kpart + (size_t)(u.pm * 2 + wr) * D + (pn - 8) * BM + bj * HALF + cw; *(f32x4*)kp = cs[bj][0]; *(f32x4*)(kp + 4) = cs[bj][1]; } }
            }
        } else if (pn < 32) {
            const int col0 = (pn - 24) * BM + cw;
#pragma unroll
            for (int ai = 0; ai < 2; ++ai)
#pragma unroll
                for (int m = 0; m < 4; ++m) { const int row = row0 + ai * HALF + m * 16; const float r = rstd_of(ss, row);
#pragma unroll
                    for (int bj = 0; bj < 2; ++bj) *(u32x4*)(GB + (size_t)row * D + col0 + bj * HALF) = pack8(acc[ai][bj][m][0] * r, acc[ai][bj][m][1] * r); }
        } else if (pn < 48) {
            const int col0 = (pn - 32) * HALF + cw;
#pragma unroll
            for (int ai = 0; ai < 2; ++ai)
#pragma unroll
                for (int m = 0; m < 4; ++m) { const int row = row0 + ai * HALF + m * 16; const float r = rstd_of(ss, row), r2 = r * r;
                    *(u32x4*)(U + (size_t)row * D + col0) = pack8(acc[ai][0][m][0] * acc[ai][1][m][0] * r2, acc[ai][0][m][1] * acc[ai][1][m][1] * r2); }
        } else {
            const int t = (pn - 48) >> 3, col0 = ((pn - 48) & 7) * BM + cw; bf16_t* base = GA + (size_t)t * ((size_t)M * D); const float* bp = bias + (pn - 48) * BM + cw;
            f32x4 bv[2][2];
#pragma unroll
            for (int bj = 0; bj < 2; ++bj) { bv[bj][0] = *(const f32x4*)(bp + bj * HALF); bv[bj][1] = *(const f32x4*)(bp + bj * HALF + 4); }
#pragma unroll
            for (int ai = 0; ai < 2; ++ai)
#pragma unroll
                for (int m = 0; m < 4; ++m) { const int row = row0 + ai * HALF + m * 16; const float r = rstd_of(ss, row);
#pragma unroll
                    for (int bj = 0; bj < 2; ++bj) *(u32x4*)(base + (size_t)row * D + col0 + bj * HALF) = pack8(sigmoid4(acc[ai][bj][m][0] * r + bv[bj][0]), sigmoid4(acc[ai][bj][m][1] * r + bv[bj][1])); }
        }
    }
};
struct EpiMix {
    static constexpr bool PERM = true, AFTER_DRAIN = false;
    float* T; const bf16_t* GA; const bf16_t* GC; bf16_t* Mo;
    __device__ __forceinline__ void operator()(const f32x4 (&acc)[2][2][4][2], const Unit& u, int wr, int wc, int fr, int fq) const {
        const bool conv = u.pn >= 8; const int pn = u.pn & 7;
        const int row0 = u.pm * BM + wr * 64 + fr, col0 = pn * BM + wc * 32 + 8 * fq;
        typedef __attribute__((address_space(1))) char gchar; typedef __attribute__((address_space(1))) f32x4 gf4; typedef __attribute__((address_space(1))) u32x4 gu4;
        gchar* tp = (gchar*)T + ((size_t)blockIdx.x * (8 * 512) + threadIdx.x) * 64;
        const size_t off0 = ((size_t)row0 * D + col0) * 2;
        const gchar* gp = (const gchar*)(conv ? GC : GA) + off0; gchar* mp = (gchar*)Mo + off0;
#pragma unroll
        for (int ai = 0; ai < 2; ++ai) {
#pragma unroll
            for (int m = 0; m < 4; ++m) {
#pragma unroll
                for (int bj = 0; bj < 2; ++bj) {
                    f32x4 g0, g1; unpack8(*(const gu4*)(gp + bj * (HALF * 2)), g0, g1);
                    if (conv) { *(gf4*)(tp + bj * 32) = acc[ai][bj][m][0] * g0; *(gf4*)(tp + bj * 32 + 16) = acc[ai][bj][m][1] * g1; }
                    else { const f32x4 t0 = *(const gf4*)(tp + bj * 32), t1 = *(const gf4*)(tp + bj * 32 + 16);
                        *(gu4*)(mp + bj * (HALF * 2)) = pack8(acc[ai][bj][m][0] * g0 + t0, acc[ai][bj][m][1] * g1 + t1); } }
                const size_t rstep = (m == 3 ? (size_t)(HALF - 48) : (size_t)16) * D * 2;
                gp += rstep; mp += rstep; tp += 512 * 64;
                asm volatile("" : "+v"(gp), "+v"(mp), "+v"(tp)); } }
    }
};
template <class Epi, class Sched, bool ALIGN_EPI = false, bool SP2 = false>
__device__ __forceinline__ void gemm_phase(PG8_LAS unsigned char* lds, const Gemm g, const Sched& S, const Epi& E) {
    const int tid = threadIdx.x, wid = __builtin_amdgcn_readfirstlane(tid >> 6), lane = tid & 63, wr = wid >> 2, wc = wid & 3, fr = lane & 15, fq = lane >> 4;
    const int K = g.K, nt = K / BK;
    unsigned voffA[2], voffB[2];
#pragma unroll
    for (int i = 0; i < 2; ++i) { int R, C; stage_rc(tid * 16 + i * 8192, R, C); const int Rb = Epi::PERM ? ((R & ~31) + perm32(R & 31)) : R;
        voffA[i] = (unsigned)(R * K + C) * 2u; voffB[i] = (unsigned)(Rb * K + C) * 2u; }
    const size_t kstep = (size_t)(BK * 2);
    const size_t hstep = (size_t)HALF * K * 2;
    const size_t tstep = 2 * hstep;
    const unsigned ldsw = (unsigned)wid * 1024u;
    const int aoff = lds_byte(wr * 64 + fr, fq * 8), boff = lds_byte(wc * 32 + fr, fq * 8);
#define PG8_SA(b, h) (((b) * 2 + (h)) * HTB)
#define PG8_SB(b, h) ((4 + (b) * 2 + (h)) * HTB)
#define PG8_STAGE(bufoff, gbase, voff) do { _Pragma("unroll") for (int _i = 0; _i < 2; ++_i) \
        __builtin_amdgcn_global_load_lds((const unsigned*)((const char*)(gbase) + (voff)[_i]), (PG8_LAS unsigned*)(lds + (bufoff) + ldsw + _i * 8192), 16, 0, 0); } while (0)
#define PG8_LDA(dst, b, h) do { _Pragma("unroll") for (int m = 0; m < 4; ++m) _Pragma("unroll") for (int k = 0; k < 2; ++k) dst[m][k] = *(const PG8_LAS bf16x8*)(lds + PG8_SA(b, h) + aoff + m * 2048 + k * 1024); } while (0)
#define PG8_LDB(dst, b, h) do { _Pragma("unroll") for (int n = 0; n < 2; ++n) _Pragma("unroll") for (int k = 0; k < 2; ++k) dst[n][k] = *(const PG8_LAS bf16x8*)(lds + PG8_SB(b, h) + boff + n * 2048 + k * 1024); } while (0)
#define PG8_MMA(ai, bj, At, Bt) do { __builtin_amdgcn_s_setprio(1); _Pragma("unroll") for (int m = 0; m < 4; ++m) _Pragma("unroll") for (int n = 0; n < 2; ++n) _Pragma("unroll") for (int k = 0; k < 2; ++k) \
        acc[ai][bj][m][n] = __builtin_amdgcn_mfma_f32_16x16x32_bf16(Bt[n][k], At[m][k], acc[ai][bj][m][n], 0, 0, 0); __builtin_amdgcn_s_setprio(0); } while (0)
#define PG8_WAIT_V(n) asm volatile("s_waitcnt vmcnt(" #n ")" ::: "memory")
#define PG8_WAIT_L(n) asm volatile("s_waitcnt lgkmcnt(" #n ")" ::: "memory")
#define PG8_BAR __builtin_amdgcn_s_barrier()
#define PG8_SCHED __builtin_amdgcn_sched_barrier(0)
    Unit cur, nxt; int ui = 0;
    if (!S.next(0, cur)) return;
    f32x4 acc[2][2][4][2];
#pragma unroll
    for (int a = 0; a < 2; ++a)
#pragma unroll
        for (int b = 0; b < 2; ++b)
#pragma unroll
            for (int m = 0; m < 4; ++m)
#pragma unroll
                for (int n = 0; n < 2; ++n) acc[a][b][m][n] = (f32x4){0.f, 0.f, 0.f, 0.f};
    bf16x8 At[4][2], B0[2][2], B1[2][2];
    const char* cA = (const char*)(cur.pn >= g.pn_split ? g.A2 : g.A) + (size_t)cur.pm * tstep; const char* cB = (const char*)g.Bt + (size_t)cur.pn * tstep;
    S.a_ready(cur);
    if constexpr (SP2) {
        PG8_STAGE(PG8_SB(0, 0), cB, voffB); PG8_STAGE(PG8_SB(0, 1), cB + hstep, voffB); PG8_STAGE(PG8_SA(0, 0), cA, voffA); PG8_STAGE(PG8_SA(0, 1), cA + hstep, voffA);
        if (wr == 1) PG8_BAR;
        PG8_WAIT_V(2); PG8_BAR;
        PG8_STAGE(PG8_SB(1, 0), cB + kstep, voffB); PG8_STAGE(PG8_SA(1, 0), cA + kstep, voffA); PG8_STAGE(PG8_SB(1, 1), cB + hstep + kstep, voffB);
        PG8_WAIT_V(6); PG8_BAR;
    } else {
        PG8_STAGE(PG8_SB(0, 0), cB, voffB); PG8_STAGE(PG8_SA(0, 0), cA, voffA); PG8_STAGE(PG8_SB(0, 1), cB + hstep, voffB); PG8_STAGE(PG8_SA(0, 1), cA + hstep, voffA);
        if (wr == 1) PG8_BAR;
        PG8_WAIT_V(4); PG8_BAR;
        PG8_STAGE(PG8_SB(1, 0), cB + kstep, voffB); PG8_STAGE(PG8_SA(1, 0), cA + kstep, voffA); PG8_STAGE(PG8_SB(1, 1), cB + hstep + kstep, voffB);
        PG8_WAIT_V(6); PG8_BAR;
    }
    for (;;) {
        const bool has_next = S.next(ui + 1, nxt);
        const char* nA = has_next ? (const char*)(nxt.pn >= g.pn_split ? g.A2 : g.A) + (size_t)nxt.pm * tstep : cA; const char* nB = has_next ? (const char*)g.Bt + (size_t)nxt.pn * tstep : cB;
        for (int t = 0; t < nt; t += 2) {
            const bool last = (t == nt - 2);
            const char* a1 = cA + (size_t)(t + 1) * kstep;
            const char* a2 = last ? nA : cA + (size_t)(t + 2) * kstep; const char* b2 = last ? nB : cB + (size_t)(t + 2) * kstep;
            const char* a3 = a2 + kstep; const char* b3 = b2 + kstep;
            if (last && has_next) S.a_ready(nxt);
            if constexpr (SP2) {
            PG8_LDB(B0, 0, 0); PG8_LDB(B1, 0, 1); PG8_SCHED; PG8_LDA(At, 0, 0); PG8_STAGE(PG8_SA(1, 1), a1 + hstep, voffA);
            PG8_WAIT_V(8); PG8_WAIT_L(0); PG8_BAR; PG8_MMA(0, 0, At, B0); PG8_MMA(0, 1, At, B1); PG8_BAR; PG8_SCHED;
            PG8_LDA(At, 0, 1); PG8_STAGE(PG8_SB(0, 0), b2, voffB); PG8_STAGE(PG8_SB(0, 1), b2 + hstep, voffB); PG8_STAGE(PG8_SA(0, 0), a2, voffA);
            PG8_WAIT_V(8); PG8_WAIT_L(0); PG8_BAR; PG8_MMA(1, 0, At, B0); PG8_MMA(1, 1, At, B1); PG8_BAR; PG8_SCHED;
            PG8_LDB(B0, 1, 0); PG8_LDB(B1, 1, 1); PG8_SCHED; PG8_LDA(At, 1, 0); PG8_STAGE(PG8_SA(0, 1), a2 + hstep, voffA);
            PG8_WAIT_V(8); PG8_WAIT_L(0); PG8_BAR; PG8_MMA(0, 0, At, B0); PG8_MMA(0, 1, At, B1); PG8_BAR; PG8_SCHED;
            PG8_LDA(At, 1, 1); PG8_STAGE(PG8_SB(1, 0), b3, voffB); PG8_STAGE(PG8_SB(1, 1), b3 + hstep, voffB); PG8_STAGE(PG8_SA(1, 0), a3, voffA);
            PG8_WAIT_V(8); PG8_WAIT_L(0); PG8_BAR; PG8_MMA(1, 0, At, B0); PG8_MMA(1, 1, At, B1); PG8_BAR; PG8_SCHED;
            } else {
            PG8_LDB(B0, 0, 0); PG8_SCHED; PG8_LDA(At, 0, 0); PG8_STAGE(PG8_SA(1, 1), a1 + hstep, voffA);
            PG8_WAIT_L(8); PG8_BAR; PG8_WAIT_L(0); PG8_MMA(0, 0, At, B0); PG8_BAR; PG8_SCHED;
            PG8_LDB(B1, 0, 1); PG8_STAGE(PG8_SB(0, 0), b2, voffB);
            PG8_BAR; PG8_WAIT_L(0); PG8_MMA(0, 1, At, B1); PG8_BAR;
            PG8_LDA(At, 0, 1); PG8_STAGE(PG8_SA(0, 0), a2, voffA);
            PG8_BAR; PG8_WAIT_L(0); PG8_MMA(1, 0, At, B0); PG8_BAR; PG8_SCHED;
            PG8_STAGE(PG8_SB(0, 1), b2 + hstep, voffB);
            PG8_WAIT_V(6); PG8_BAR; PG8_MMA(1, 1, At, B1); PG8_BAR;
            PG8_LDB(B0, 1, 0); PG8_SCHED; PG8_LDA(At, 1, 0); PG8_STAGE(PG8_SA(0, 1), a2 + hstep, voffA);
            PG8_WAIT_L(8); PG8_BAR; PG8_WAIT_L(0); PG8_MMA(0, 0, At, B0); PG8_BAR; PG8_SCHED;
            PG8_LDB(B1, 1, 1); PG8_STAGE(PG8_SB(1, 0), b3, voffB);
            PG8_BAR; PG8_WAIT_L(0); PG8_MMA(0, 1, At, B1); PG8_BAR;
            PG8_LDA(At, 1, 1); PG8_STAGE(PG8_SA(1, 0), a3, voffA);
            PG8_BAR; PG8_WAIT_L(0); PG8_MMA(1, 0, At, B0); PG8_BAR; PG8_SCHED;
            PG8_STAGE(PG8_SB(1, 1), b3 + hstep, voffB);
            PG8_WAIT_V(6); PG8_BAR; PG8_MMA(1, 1, At, B1); PG8_BAR;
            }
        }
        if constexpr (ALIGN_EPI) { if (wr == 0) PG8_BAR; }
        if constexpr (!Epi::AFTER_DRAIN) { E(acc, cur, wr, wc, fr, fq); S.done(cur); }
        if (!has_next) break;
#pragma unroll
        for (int a = 0; a < 2; ++a)
#pragma unroll
            for (int b = 0; b < 2; ++b)
#pragma unroll
                for (int m = 0; m < 4; ++m)
#pragma unroll
                    for (int n = 0; n < 2; ++n) acc[a][b][m][n] = (f32x4){0.f, 0.f, 0.f, 0.f};
        cur = nxt; cA = nA; cB = nB; ++ui;
        if constexpr (ALIGN_EPI) { if (wr == 1) PG8_BAR; }
    }
    PG8_WAIT_V(0);
    if constexpr (!ALIGN_EPI) { if (wr == 0) PG8_BAR; }
    PG8_BAR;
    if constexpr (Epi::AFTER_DRAIN) { E.fused(acc, cur, wr, wc, fr, fq, lds, wid, lane); S.done(cur); }
#undef PG8_SA
#undef PG8_SB
#undef PG8_STAGE
#undef PG8_LDA
#undef PG8_LDB
#undef PG8_MMA
#undef PG8_WAIT_V
#undef PG8_WAIT_L
#undef PG8_BAR
#undef PG8_SCHED
}
}
constexpr int NWAVES = 8;
constexpr size_t MiB = 1u << 20;
constexpr size_t WS_CTL = 0, CTL_ZERO_BYTES = 1 * MiB;
constexpr size_t WS_W1 = 1 * MiB;
constexpr size_t WS_W2 = WS_W1 + 44 * MiB;
constexpr size_t WS_WIN = WS_W2 + 22 * MiB;
constexpr size_t WS_WA = WS_WIN + 64 * MiB;
constexpr size_t WS_WC = WS_WA + 8 * MiB;
constexpr size_t WS_WO = WS_WC + 8 * MiB;
constexpr size_t WS_W3 = WS_WO + 8 * MiB;
constexpr size_t WS_W4 = WS_W3 + 44 * MiB;
constexpr size_t WS_XB = WS_W4 + 22 * MiB;
constexpr size_t WS_Z = WS_XB + 32 * MiB;
constexpr size_t WS_Q = WS_Z, WS_K = WS_Z + 32 * MiB, WS_V = WS_Z + 64 * MiB, WS_GB = WS_Z + 96 * MiB, WS_U = WS_Z + 128 * MiB,
                 WS_GA = WS_Z + 160 * MiB, WS_GC = WS_Z + 192 * MiB;
constexpr size_t WS_H = WS_Z;
constexpr size_t WS_T = WS_K;
constexpr size_t WS_M = WS_U;
constexpr size_t WS_O = WS_Z + 224 * MiB;
constexpr size_t WS_END = WS_O + 32 * MiB;
constexpr int CW_TMO = 0, CW_CODE = 1, CW_BAR = 4096;
constexpr int CW_SS1 = 32768, CW_SS2 = 40960, CW_SS3 = 49152, CW_SS4 = 57344;
constexpr int CW_KM = 65536;
constexpr int CW_KPART = 131072;
constexpr int RING_OFF = 0, RING_BYTES = 131072;
constexpr int ATT_LDS_END = 67584 + 65536;
constexpr int LDSCTL_OFF = ATT_LDS_END, MISC_OFF = LDSCTL_OFF + 320;
constexpr int LDS_BYTES = 147456;
static_assert(MISC_OFF + 128 <= LDS_BYTES, "LDS map");
#define GAS __attribute__((address_space(1)))
#define LAS __attribute__((address_space(3)))
typedef unsigned short bf16;
typedef unsigned v4u __attribute__((ext_vector_type(4)));
typedef float f32x4 __attribute__((ext_vector_type(4)));
typedef short bf16x8 __attribute__((ext_vector_type(8)));
typedef GAS unsigned gu32;
typedef GAS unsigned long long gu64;
#define RLX_AGENT __ATOMIC_RELAXED, __HIP_MEMORY_SCOPE_AGENT
#define LDS_WAIT() asm volatile("s_waitcnt lgkmcnt(0)" ::: "memory")
#define VM_WAIT() asm volatile("s_waitcnt vmcnt(0)" ::: "memory")
__device__ __forceinline__ unsigned long long rt() { return __builtin_amdgcn_s_memrealtime(); }
__device__ __forceinline__ unsigned f2bf(float f) { unsigned u = __builtin_bit_cast(unsigned, f); return (u + 0x7fffu + ((u >> 16) & 1u)) >> 16; }
__device__ __forceinline__ unsigned pk2(float lo, float hi) { return f2bf(lo) | (f2bf(hi) << 16); }

#define XB_TMO      128
#define XB_XCNT(j)  (256  + 64 * (j))
#define XB_XSUB(j)  (1280 + 64 * (j))
#define XB_XGEN(j)  (2304 + 64 * (j))
#define XB_TOP      3328
#define XB_TOPGEN   3392
#define XCD_BAR_WORDS 3456
#define XB_SPIN_CAP (1u << 18)

__device__ __forceinline__ unsigned xb_ld(unsigned* p)              { return __hip_atomic_load(p, __ATOMIC_RELAXED, __HIP_MEMORY_SCOPE_AGENT); }
__device__ __forceinline__ unsigned xb_add(unsigned* p, unsigned v) { return __hip_atomic_fetch_add(p, v, __ATOMIC_RELAXED, __HIP_MEMORY_SCOPE_AGENT); }
__device__ __forceinline__ unsigned xb_xcc_id() { return (unsigned)__builtin_amdgcn_s_getreg((3 << 11) | 20) & 0xFu; }
#define XB_SPIN(cond, bar) do { unsigned _sp = 0; while (cond) { __builtin_amdgcn_s_sleep(1); \
    if ((++_sp & 255u) == 0u) { if (xb_ld(&(bar)[XB_TMO])) break; if (_sp > XB_SPIN_CAP) { atomicAdd(&(bar)[XB_TMO], 1u); break; } } } } while (0)

struct XcdBarrier {
    unsigned* bar; unsigned x;
    volatile LAS unsigned* st;
};

__device__ __forceinline__ XcdBarrier xcd_barrier_post(unsigned* bar, volatile LAS unsigned* st) {
    XcdBarrier b; b.bar = bar; b.x = xb_xcc_id(); b.st = st;
    if (threadIdx.x == 0) (void)xb_add(&bar[XB_XCNT(b.x)], 1u);
    return b;
}
__device__ __forceinline__ void xcd_barrier_complete(unsigned* bar, unsigned x, unsigned& nloc, unsigned& nx) {
    const unsigned G = gridDim.x * gridDim.y * gridDim.z;
    unsigned sum, cnt, mine, sp = 0u;
    for (;;) {
        sum = 0u; cnt = 0u; mine = 0u;
#pragma unroll
        for (unsigned j = 0; j < 16; ++j) { const unsigned c = xb_ld(&bar[XB_XCNT(j)]); sum += c; cnt += (c > 0u) ? 1u : 0u; mine = (j == x) ? c : mine; }
        if (sum == G) break;
        __builtin_amdgcn_s_sleep(1);
        if ((++sp & 255u) == 0u) { if (xb_ld(&bar[XB_TMO])) break; if (sp > XB_SPIN_CAP) { atomicAdd(&bar[XB_TMO], 1u); break; } }
    }
    nloc = mine > 0u ? mine : 1u; nx = cnt > 0u ? cnt : 1u;
}

__device__ __forceinline__ void xcd_barrier(const XcdBarrier& b) {
    asm volatile("s_waitcnt vmcnt(0)" ::: "memory");
    __syncthreads();
    if (threadIdx.x == 0) {
        unsigned* bar = b.bar;
        __builtin_amdgcn_s_waitcnt(0);
        unsigned nloc = b.st[0], nx = b.st[1];
        if (nloc == 0u) { xcd_barrier_complete(bar, b.x, nloc, nx); b.st[0] = nloc; b.st[1] = nx; }
        const unsigned old = xb_add(&bar[XB_XSUB(b.x)], 1u);
        const unsigned gen = old / nloc;
        if (old + 1u == (gen + 1u) * nloc) {
            __builtin_amdgcn_fence(__ATOMIC_RELEASE, "agent");
            asm volatile("s_waitcnt vmcnt(0)" ::: "memory");
            const unsigned og = xb_add(&bar[XB_TOP], 1u);
            const unsigned tg = og / nx;
            if (og + 1u == (tg + 1u) * nx) xb_add(&bar[XB_TOPGEN], 1u);
            else XB_SPIN(xb_ld(&bar[XB_TOPGEN]) == tg, bar);
            __builtin_amdgcn_fence(__ATOMIC_ACQUIRE, "agent");
            xb_add(&bar[XB_XGEN(b.x)], 1u);
            asm volatile("s_waitcnt vmcnt(0)" ::: "memory");
        } else {
            XB_SPIN(xb_ld(&bar[XB_XGEN(b.x)]) == gen, bar);
            __builtin_amdgcn_fence(__ATOMIC_ACQUIRE, "agent");
            asm volatile("s_waitcnt vmcnt(0)" ::: "memory");
        }
    }
    __syncthreads();
}

namespace attn {
constexpr int D = 128, OSTR = 2048;
constexpr float THR = 8.f;
constexpr float SCALE = 0.08838834764831845f;
constexpr int NW = 8, QBLK = 32, KVBLK = 64, QB = NW * QBLK;
constexpr int SHM_V = KVBLK * D * 2, SHM_K = KVBLK * D * 2;
constexpr int LDS_BYTES = 2 * SHM_V + 2 * SHM_K + NW * 64 * 4;


typedef unsigned short bf16;
typedef short bf16x8 __attribute__((ext_vector_type(8)));
typedef short s16x4 __attribute__((ext_vector_type(4)));
typedef float f32x16 __attribute__((ext_vector_type(16)));
typedef float f32x4 __attribute__((ext_vector_type(4)));
typedef unsigned u32x4 __attribute__((ext_vector_type(4)));
template <class A, class Bt> struct same_t { static constexpr bool v = false; };
template <class A> struct same_t<A, A> { static constexpr bool v = true; };

#define KSWZ(row, colB) ((row) * 256 + ((colB) ^ (((row) & 7) << 4)))
#define SBAR() __builtin_amdgcn_sched_barrier(0)
__device__ __forceinline__ int v_st(int k, int c) { const int kk = (k & ~0xC) | ((k & 4) << 1) | ((k & 8) >> 1); return ((kk >> 3) * 4 + (c >> 5)) * 512 + ((kk & 7) * 32 + (c & 31)) * 2; }
__device__ __forceinline__ int v_rd_base(int lane) { return ((lane & 3) << 3) | (((lane >> 2) & 3) << 6) | (((lane >> 4) & 1) << 5) | (((lane >> 5) & 1) << 8); }
constexpr int v_rd_off(int d0, int ks, int half) { return d0 * 512 + ks * 4096 + half * 2048; }
__device__ __forceinline__ int crow(int r, int hi) { return (r & 3) + 8 * (r >> 2) + 4 * hi; }
__device__ __forceinline__ unsigned cvtpk(float lo, float hi) {
    unsigned r; asm volatile("v_cvt_pk_bf16_f32 %0, %1, %2" : "=v"(r) : "v"(lo), "v"(hi)); return r;
}
__device__ __forceinline__ bf16x8 pack8(f32x4 a, f32x4 b) {
    u32x4 w = {cvtpk(a[0], a[1]), cvtpk(a[2], a[3]), cvtpk(b[0], b[1]), cvtpk(b[2], b[3])};
    return *reinterpret_cast<bf16x8*>(&w);
}
template <class T> __device__ __forceinline__ bf16x8 load8(const T* p) {
    if constexpr (same_t<T, float>::v) { return pack8(*(const f32x4*)p, *(const f32x4*)(p + 4)); }
    else { return *reinterpret_cast<const bf16x8*>(p); }
}
__device__ __forceinline__ void mask_tile(f32x16& p0, f32x16& p1, int dq, unsigned W) {
    const float NEG = -__builtin_inff();
#pragma unroll
    for (int r = 0; r < 16; ++r) {
        const int c = (r & 3) + 8 * (r >> 2);
        if ((unsigned)(dq - c) >= W) p0[r] = NEG;
        if ((unsigned)(dq - c - 32) >= W) p1[r] = NEG;
    }
}
__device__ __forceinline__ void partialSM(f32x16& p0, f32x16& p1, float& m_reg, float& mn, float& alpha) {
    float pmax = p0[0]; for (int r = 1; r < 16; ++r) pmax = fmaxf(pmax, p0[r]); for (int r = 0; r < 16; ++r) pmax = fmaxf(pmax, p1[r]);
    { auto rr = __builtin_amdgcn_permlane32_swap(__float_as_uint(pmax), __float_as_uint(pmax), false, false);
      pmax = fmaxf(__uint_as_float(rr[0]), __uint_as_float(rr[1])); }
    constexpr float C2 = 1.4426950408889634f * SCALE;
    if (__builtin_expect(__all((pmax - m_reg) * SCALE <= THR), 1)) { mn = m_reg; alpha = 1.f; }
    else { mn = fmaxf(m_reg, pmax); alpha = __builtin_amdgcn_exp2f((m_reg - mn) * C2); m_reg = mn; }
    const float mnL = -mn * C2;
    for (int r = 0; r < 16; ++r) p0[r] = fmaf(p0[r], C2, mnL); for (int r = 0; r < 16; ++r) p1[r] = fmaf(p1[r], C2, mnL);
    for (int r = 0; r < 16; ++r) p0[r] = __builtin_amdgcn_exp2f(p0[r]);
}
__device__ __forceinline__ void finishSM(f32x16& p0, f32x16& p1, float alpha, float& l_reg, bf16x8& pa0, bf16x8& pa1, bf16x8& pa2, bf16x8& pa3) {
    for (int r = 0; r < 16; ++r) p1[r] = __builtin_amdgcn_exp2f(p1[r]);
    float ps = 0; for (int r = 0; r < 16; ++r) ps += p0[r]; for (int r = 0; r < 16; ++r) ps += p1[r];
    { auto rr = __builtin_amdgcn_permlane32_swap(__float_as_uint(ps), __float_as_uint(ps), false, false);
      ps = __uint_as_float(rr[0]) + __uint_as_float(rr[1]); }
    l_reg = l_reg * alpha + ps;
#define PK4(P, B_, OUT) do { unsigned a0 = cvtpk(P[B_+0], P[B_+1]), a1 = cvtpk(P[B_+2], P[B_+3]);                          \
        unsigned b0 = cvtpk(P[B_+4], P[B_+5]), b1 = cvtpk(P[B_+6], P[B_+7]);                                             \
        auto r0 = __builtin_amdgcn_permlane32_swap(a0, b0, false, false); auto r1 = __builtin_amdgcn_permlane32_swap(a1, b1, false, false); \
        u32x4 w = {r0[0], r1[0], r0[1], r1[1]}; OUT = *reinterpret_cast<bf16x8*>(&w); } while (0)
    PK4(p0, 0, pa0); PK4(p0, 8, pa1); PK4(p1, 0, pa2); PK4(p1, 8, pa3);
#undef PK4
}
template <int KB, bool SK>
__device__ __forceinline__ void qkt(f32x16& p0, f32x16& p1, const char* K_lds, int r32, int hi, const char* Qw, bool act, float Aal, float ab) {
    if (SK && !act) { const float NEG = -__builtin_inff();
#pragma unroll
        for (int r = 0; r < 16; ++r) { p0[r] = NEG; p1[r] = NEG; } return; }
#pragma unroll
    for (int r = 0; r < 16; ++r) { const float c = (float)((r & 3) + 8 * (r >> 2)); p0[r] = fmaf(Aal, c, ab); p1[r] = fmaf(Aal, c + 32.f, ab); }
    const char* kb[4]; const char* qa[4];
#pragma unroll
    for (int dd = 0; dd < 4; ++dd) { kb[dd] = K_lds + KB * SHM_K + KSWZ(r32, (dd * 16 + hi * 8) * 2); qa[dd] = Qw + KSWZ(r32, (dd * 16 + hi * 8) * 2); }
#pragma unroll
    for (int d0 = 0; d0 < 8; ++d0) { const char* a = kb[d0 & 3] + (d0 >> 2) * 128;
        bf16x8 b0 = *reinterpret_cast<const bf16x8*>(a);
        bf16x8 b1 = *reinterpret_cast<const bf16x8*>(a + 32 * 256);
        bf16x8 qf = *reinterpret_cast<const bf16x8*>(qa[d0 & 3] + (d0 >> 2) * 128);
        p0 = __builtin_amdgcn_mfma_f32_32x32x16_bf16(b0, qf, p0, 0, 0, 0);
        p1 = __builtin_amdgcn_mfma_f32_32x32x16_bf16(b1, qf, p1, 0, 0, 0); }
}
template <int VB, bool SK>
__device__ __forceinline__ void pv_tile(f32x16* o, int vb0, bf16x8 pa0, bf16x8 pa1, bf16x8 pa2, bf16x8 pa3, bool act) {
    if (SK && !act) return;
#define TRRD(dst, off) asm volatile("ds_read_b64_tr_b16 %0, %1 offset:%2" : "=&v"(dst) : "v"(vb0), "i"(off) : "memory")
#define PV_D0(d0) do { s16x4 l0, l1, l2, l3, h0, h1, h2, h3; constexpr int b_ = VB * SHM_V + v_rd_off(d0, 0, 0);     \
        TRRD(l0, b_); TRRD(h0, b_ + 2048); TRRD(l1, b_ + 4096); TRRD(h1, b_ + 6144); TRRD(l2, b_ + 8192); TRRD(h2, b_ + 10240); TRRD(l3, b_ + 12288); TRRD(h3, b_ + 14336); \
        asm volatile("s_waitcnt lgkmcnt(0)" ::: "memory"); SBAR();                 \
        o[d0] = __builtin_amdgcn_mfma_f32_32x32x16_bf16(pa0, (bf16x8){l0[0], l0[1], l0[2], l0[3], h0[0], h0[1], h0[2], h0[3]}, o[d0], 0, 0, 0);   \
        o[d0] = __builtin_amdgcn_mfma_f32_32x32x16_bf16(pa1, (bf16x8){l1[0], l1[1], l1[2], l1[3], h1[0], h1[1], h1[2], h1[3]}, o[d0], 0, 0, 0);   \
        o[d0] = __builtin_amdgcn_mfma_f32_32x32x16_bf16(pa2, (bf16x8){l2[0], l2[1], l2[2], l2[3], h2[0], h2[1], h2[2], h2[3]}, o[d0], 0, 0, 0);   \
        o[d0] = __builtin_amdgcn_mfma_f32_32x32x16_bf16(pa3, (bf16x8){l3[0], l3[1], l3[2], l3[3], h3[0], h3[1], h3[2], h3[3]}, o[d0], 0, 0, 0); } while (0)
    PV_D0(0); PV_D0(1); PV_D0(2); PV_D0(3);
#undef PV_D0
#undef TRRD
}

template <class TIn, class TOut> struct BlockRef { const TIn* Q; const TIn* K; const TIn* V; TOut* O; int P0; const float* km; float Aal; };
template <class TIn> struct Seam {
    bf16x8 qr[8];
    bf16x8 st_v0, st_v1, st_k0, st_k1; f32x4 sf0, sf1, sf2, sf3;
    f32x4 tq[16];
};
__device__ __forceinline__ int swa_jlo(int P0, int W) { const int lowk = P0 - W + 1; return lowk > 0 ? lowk / KVBLK : 0; }
#define ROW(p, k0, rr) ((p) + (size_t)((k0) + (rr)) * D + sc)
#define VMW() asm volatile("s_waitcnt vmcnt(0)" ::: "memory")
#define VMWN(n) asm volatile("s_waitcnt vmcnt(%0)" :: "i"(n) : "memory")
#define SLOAD_H(Kp, Vp, k0) do { S.st_v0 = load8<TIn>(ROW(Vp, k0, sr)); S.st_v1 = load8<TIn>(ROW(Vp, k0, 32 + sr));              \
                         S.st_k0 = load8<TIn>(ROW(Kp, k0, sr)); S.st_k1 = load8<TIn>(ROW(Kp, k0, 32 + sr)); } while (0)
#define SWRITE_HK(bf) do { *(bf16x8*)(K_lds + (bf) * SHM_K + kws) = S.st_k0; *(bf16x8*)(K_lds + (bf) * SHM_K + kws + 32 * 256) = S.st_k1; } while (0)
#define SWRITE_HV(bf) do { *(bf16x8*)(V_lds + (bf) * SHM_V + vst0) = S.st_v0; *(bf16x8*)(V_lds + (bf) * SHM_V + vst1) = S.st_v1; } while (0)
#define SWRITE_H(bf) do { SWRITE_HV(bf); SWRITE_HK(bf); } while (0)
#define SLOAD_F(p, k0) do { S.sf0 = *(const f32x4*)ROW(p, k0, sr); S.sf1 = *(const f32x4*)(ROW(p, k0, sr) + 4);                \
                            S.sf2 = *(const f32x4*)ROW(p, k0, 32 + sr); S.sf3 = *(const f32x4*)(ROW(p, k0, 32 + sr) + 4); } while (0)
#define SWRITE_KF(bf) do { *(bf16x8*)(K_lds + (bf) * SHM_K + kws) = pack8(S.sf0, S.sf1); *(bf16x8*)(K_lds + (bf) * SHM_K + kws + 32 * 256) = pack8(S.sf2, S.sf3); } while (0)
#define SWRITE_VF(bf) do { *(bf16x8*)(V_lds + (bf) * SHM_V + vst0) = pack8(S.sf0, S.sf1); *(bf16x8*)(V_lds + (bf) * SHM_V + vst1) = pack8(S.sf2, S.sf3); } while (0)
template <class TIn, class TOut>
__device__ __forceinline__ void causal_swa_prime(const BlockRef<TIn, TOut>& cur, int W, char* lds, Seam<TIn>& S) {
    constexpr bool F32 = same_t<TIn, float>::v;
    const int tid = threadIdx.x, wid = __builtin_amdgcn_readfirstlane(tid >> 6), lane = tid & 63, r32 = lane & 31, hi = lane >> 5;
    const int sr = tid >> 4, sc = (tid & 15) * 8, kws = KSWZ(sr, sc * 2); char* K_lds = lds + 2 * SHM_V;
    const int kb0 = swa_jlo(cur.P0, W) * KVBLK;
    for (int d0 = 0; d0 < 8; ++d0) S.qr[d0] = load8<TIn>(cur.Q + (size_t)(wid * QBLK + r32) * D + d0 * 16 + hi * 8);
    if constexpr (F32) { SLOAD_F((const float*)cur.K, kb0); VMW(); SWRITE_KF(0); SBAR(); SLOAD_F((const float*)cur.V, kb0); }
    else { SLOAD_H(cur.K, cur.V, kb0); VMW(); SWRITE_HK(0); }
    { char* Qw = lds + LDS_BYTES + wid * 8192;
#pragma unroll
      for (int d0 = 0; d0 < 8; ++d0) *(bf16x8*)(Qw + KSWZ(r32, (d0 * 16 + hi * 8) * 2)) = S.qr[d0]; }
    __syncthreads();
}
template <class TIn, class TOut>
__device__ __forceinline__ void causal_swa_block(const BlockRef<TIn, TOut>& cur, const BlockRef<TIn, TOut>& nxt, int skv, int W, char* lds, Seam<TIn>& S) {
    constexpr bool F32 = same_t<TIn, float>::v;
    const int tid = threadIdx.x, wid = __builtin_amdgcn_readfirstlane(tid >> 6), lane = tid & 63, r32 = lane & 31, hi = lane >> 5;
    const int j_lo = swa_jlo(cur.P0, W);
    int j_hi = (cur.P0 + QB - 1) / KVBLK + 1; if (j_hi > skv / KVBLK) j_hi = skv / KVBLK;
    const int NT = j_hi - j_lo;
    const int kbn = swa_jlo(nxt.P0, W) * KVBLK;
    const int qb = cur.P0 >> 8; const float Aal = cur.Aal; const int aref = cur.P0 + QB - 1 - 4 * hi;
    const int qlo = cur.P0 + wid * QBLK, qm = qlo + r32 - 4 * hi;
    char* V_lds = lds; char* K_lds = lds + 2 * SHM_V; char* Qw = lds + LDS_BYTES + wid * 8192;
    float* ws = (float*)(lds + 2 * SHM_V + 2 * SHM_K) + wid * 64; float* li_l = ws, * al_l = ws + 32;
    float m_reg = -1e30f, l_reg = 0; f32x16 o[4] = {};
    const int sr = tid >> 4, sc = (tid & 15) * 8, vst0 = v_st(sr, sc), vst1 = v_st(32 + sr, sc), kws = KSWZ(sr, sc * 2);
    const int vb0 = (int)(uintptr_t)V_lds + v_rd_base(lane);
    const TIn* Kh = cur.K; const TIn* Vh = cur.V;
#define RESC(a) do { if (__any((a) < 1.f)) { if (hi == 0) al_l[r32] = (a); asm volatile("s_waitcnt lgkmcnt(0)" ::: "memory");              \
                     for (int d_ = 0; d_ < 4; ++d_) for (int r = 0; r < 16; ++r) o[d_][r] *= al_l[crow(r, hi)]; } } while (0)
#define KBASE(t) ((j_lo + (t)) * KVBLK)
#define ACT(t) (KBASE(t) <= qlo + QBLK - 1 && KBASE(t) + KVBLK - 1 >= qlo - W + 1)
#define AB(t) (Aal * (float)(KBASE(t) - aref))
#define MASKT(P0_, P1_, t) do { const int kb_ = KBASE(t); const int jb_ = kb_ >> 8;                                         \
        if (jb_ == qb) { if (kb_ + KVBLK - 1 > qlo) mask_tile(P0_, P1_, qm - kb_, 0x7fffffffu); }                          \
        else if (qb > 3) { const bool on_ = ((sel >> jb_) & 1) != 0; if (!__all(on_)) { const float NEG_ = -__builtin_inff();   \
            _Pragma("unroll") for (int r_ = 0; r_ < 16; ++r_) { P0_[r_] = on_ ? P0_[r_] : NEG_; P1_[r_] = on_ ? P1_[r_] : NEG_; } } } } while (0)
    constexpr int NQL = F32 ? 16 : 8;
    constexpr bool SK = false;
#define SEAM_K0() do { VMWN(NQL); if constexpr (F32) { SWRITE_KF(0); SBAR(); SLOAD_F((const float*)nxt.V, kbn); } else { SWRITE_HK(0); } SBAR(); } while (0)
    f32x16 pA0, pA1, pB0, pB1; float mnA, mnB, alA, alB; bf16x8 pa0, pa1, pa2, pa3;
    int sel = (1 << qb) - 1;
    if (qb > 3) {
        float v1 = -__builtin_inff(), v2 = v1, v3 = v1; int m1 = 0, m2 = 0, m3 = 0;
#pragma nounroll
        for (int j = 0; j < qb; ++j) { const float* k0 = cur.km + (size_t)(2 * j) * 2048 + hi * 8; float acc = 0.f;
#pragma unroll
            for (int d0 = 0; d0 < 8; ++d0) { const f32x4 a0 = *(const f32x4*)(k0 + d0 * 16) + *(const f32x4*)(k0 + 2048 + d0 * 16), a1 = *(const f32x4*)(k0 + d0 * 16 + 4) + *(const f32x4*)(k0 + 2048 + d0 * 16 + 4);
                const bf16x8 q = S.qr[d0];
#pragma unroll
                for (int e = 0; e < 4; ++e) { acc = fmaf(__builtin_bit_cast(float, (unsigned)(unsigned short)q[e] << 16), a0[e], acc); acc = fmaf(__builtin_bit_cast(float, (unsigned)(unsigned short)q[e + 4] << 16), a1[e], acc); } }
            { auto rr = __builtin_amdgcn_permlane32_swap(__float_as_uint(acc), __float_as_uint(acc), false, false); acc = __uint_as_float(rr[0]) + __uint_as_float(rr[1]); }
            const int mj = 1 << j; const bool g1 = acc > v1, g2 = acc > v2, g3 = acc > v3;
            v3 = g2 ? v2 : (g3 ? acc : v3); m3 = g2 ? m2 : (g3 ? mj : m3);
            v2 = g1 ? v1 : (g2 ? acc : v2); m2 = g1 ? m1 : (g2 ? mj : m2);
            v1 = g1 ? acc : v1; m1 = g1 ? mj : m1; }
        sel = m1 | m2 | m3;
    }
    if constexpr (F32) { VMW(); SWRITE_VF(0); SBAR(); } else { SWRITE_HV(0); SBAR(); }
    if (NT > 1) { if constexpr (F32) SLOAD_F((const float*)Kh, KBASE(1)); else SLOAD_H(Kh, Vh, KBASE(1)); }
    SBAR(); qkt<0, SK>(pA0, pA1, K_lds, r32, hi, Qw, ACT(0), Aal, AB(0));
    if constexpr (F32) { if (NT > 1) { VMW(); SWRITE_KF(1); SBAR(); SLOAD_F((const float*)Vh, KBASE(1)); } }
    MASKT(pA0, pA1, 0); partialSM(pA0, pA1, m_reg, mnA, alA);
    if (NT > 1) { VMW(); if constexpr (F32) { SWRITE_VF(1); SBAR(); if (NT > 2) SLOAD_F((const float*)Kh, KBASE(2)); } else SWRITE_H(1); }
    __syncthreads();
#define HALF_STEP(PX0, PX1, mnX, alX, PY0, PY1, alY, t, KB, VB, SB) do {                                                      \
        SBAR(); qkt<KB, SK>(PX0, PX1, K_lds, r32, hi, Qw, ACT(t), Aal, AB(t));                                             \
        finishSM(PY0, PY1, alY, l_reg, pa0, pa1, pa2, pa3); SBAR();                                                           \
        if ((t) + 1 < NT) { if constexpr (F32) { VMW(); SWRITE_KF(SB); SBAR(); SLOAD_F((const float*)Vh, KBASE((t) + 1)); }  \
                            else { SLOAD_H(Kh, Vh, KBASE((t) + 1)); } SBAR(); }                                               \
        pv_tile<VB, SK>(o, vb0, pa0, pa1, pa2, pa3, ACT((t) - 1)); MASKT(PX0, PX1, (t)); partialSM(PX0, PX1, m_reg, mnX, alX);                                        \
        __syncthreads();                                                                                                      \
        if ((t) + 1 < NT) { VMW(); if constexpr (F32) { SWRITE_VF(SB); SBAR(); if ((t) + 2 < NT) SLOAD_F((const float*)Kh, KBASE((t) + 2)); } \
                            else { SWRITE_H(SB); } }                                                                          \
        RESC(alX); __syncthreads(); } while (0)
    for (int t = 1; t + 1 < NT; t += 2) {
        HALF_STEP(pB0, pB1, mnB, alB, pA0, pA1, alA, t, 1, 0, 0);
        HALF_STEP(pA0, pA1, mnA, alA, pB0, pB1, alB, t + 1, 0, 1, 1);
    }
    const bool even = (NT & 1) == 0;
    if (even) { SBAR(); qkt<1, SK>(pB0, pB1, K_lds, r32, hi, Qw, ACT(NT - 1), Aal, AB(NT - 1)); SBAR(); }
#define QROW(e) (nxt.Q + (size_t)(wid * QBLK + r32) * D + ((e) >> 1) * 16 + hi * 8 + ((e) & 1) * 4)
    if constexpr (F32) { SLOAD_F((const float*)nxt.K, kbn); SBAR();
#pragma unroll
        for (int e = 0; e < 8; ++e) S.tq[e] = *(const f32x4*)QROW(e); }
    else { SLOAD_H(nxt.K, nxt.V, kbn); SBAR();
#pragma unroll
        for (int d0 = 0; d0 < 8; ++d0) S.qr[d0] = load8<TIn>(nxt.Q + (size_t)(wid * QBLK + r32) * D + d0 * 16 + hi * 8); }
    SBAR();
    finishSM(pA0, pA1, alA, l_reg, pa0, pa1, pa2, pa3); SBAR();
    if constexpr (F32) {
#pragma unroll
        for (int e = 8; e < 16; ++e) S.tq[e] = *(const f32x4*)QROW(e); SBAR(); }
#undef QROW
    pv_tile<0, SK>(o, vb0, pa0, pa1, pa2, pa3, ACT(even ? NT - 2 : NT - 1));
    if (even) { MASKT(pB0, pB1, NT - 1); partialSM(pB0, pB1, m_reg, mnB, alB); __syncthreads(); RESC(alB);
        finishSM(pB0, pB1, alB, l_reg, pa0, pa1, pa2, pa3); SBAR(); pv_tile<1, SK>(o, vb0, pa0, pa1, pa2, pa3, ACT(NT - 1)); }
    SBAR(); SEAM_K0();
    if (hi == 0) li_l[r32] = l_reg; asm volatile("s_waitcnt lgkmcnt(0)" ::: "memory");
    float rli[16];
#pragma unroll
    for (int r = 0; r < 16; ++r) rli[r] = __builtin_amdgcn_rcpf(li_l[crow(r, hi)]);
    TOut* Ow = cur.O + (size_t)(wid * QBLK) * OSTR;
#pragma unroll
    for (int r = 0; r < 16; ++r) { const int orow = crow(r, hi);
#pragma unroll
        for (int d0 = 0; d0 < 4; ++d0) { const float v = o[d0][r] * rli[r];
            if constexpr (same_t<TOut, float>::v) { Ow[(size_t)orow * OSTR + d0 * 32 + r32] = v; }
            else { const float vn = __shfl_xor(v, 1);
                   if ((r32 & 1) == 0) *(unsigned*)(Ow + (size_t)orow * OSTR + d0 * 32 + r32) = cvtpk(v, vn); } } }
    if constexpr (F32) {
#pragma unroll
        for (int d0 = 0; d0 < 8; ++d0) S.qr[d0] = pack8(S.tq[2 * d0], S.tq[2 * d0 + 1]); }
    VMW();
#pragma unroll
    for (int d0 = 0; d0 < 8; ++d0) *(bf16x8*)(Qw + KSWZ(r32, (d0 * 16 + hi * 8) * 2)) = S.qr[d0];
    __syncthreads();
#undef RESC
#undef KBASE
#undef ACT
#undef MASKT
#undef AB
#undef SEAM_K0
#undef HALF_STEP
}
#undef ROW
#undef VMW
#undef VMWN
#undef SLOAD_H
#undef SWRITE_HK
#undef SWRITE_HV
#undef SWRITE_H
#undef SLOAD_F
#undef SWRITE_KF
#undef SWRITE_VF

}

struct Frame {
    LAS unsigned char* lds;
    volatile LAS unsigned* MISC;
    gu32* ctl;
    int tid, lane, wave;
    int vcu, G;
};
__device__ __forceinline__ float wave_sum(float v) {
#pragma unroll
    for (int o = 1; o < 64; o <<= 1) v += __shfl_xor(v, o);
    return v;
}
__device__ __forceinline__ void p0_item(const float* src, int Nsrc, int sc, const float* g, bf16* WT, int K, int nrow0, int k0, LAS float* scr, int lane) {
#pragma unroll 8
    for (int i = 0; i < 32; ++i) { const int kk = 2 * i + (lane >> 5); float v = src[(size_t)(k0 + kk) * Nsrc + sc + (lane & 31)]; if (g) v *= g[k0 + kk]; scr[kk * 33 + (lane & 31)] = v; }
    LDS_WAIT(); asm volatile("" ::: "memory");
    const int c = lane & 7;
#pragma unroll
    for (int j = 0; j < 4; ++j) { const int n = (lane >> 3) + 8 * j; const LAS float* s = scr + (8 * c) * 33 + n;
        v4u o; o.x = pk2(s[0 * 33], s[1 * 33]); o.y = pk2(s[2 * 33], s[3 * 33]); o.z = pk2(s[4 * 33], s[5 * 33]); o.w = pk2(s[6 * 33], s[7 * 33]);
        *(GAS v4u*)(WT + (size_t)(nrow0 + n) * K + k0 + 8 * c) = o; }
    LDS_WAIT(); asm volatile("" ::: "memory");
}
struct Args { const float* in[17]; float* out; unsigned char* ws; int ph_lo, ph_hi, li, pad; };

__device__ __forceinline__ void p0_prologue(Frame& F, const Args& a) {
    LAS float* scr = (LAS float*)(F.lds + RING_OFF + F.wave * 16384);
    const int gw = F.vcu * NWAVES + F.wave, NGW = F.G * NWAVES;
    unsigned char* ws = a.ws;
    constexpr int I_DUAL = (D / 64) * (2 * FF / 32), I_DOWN = (FF / 64) * (D / 32), I_IN = (D / 64) * (INW / 32), I_SQ = (D / 64) * (D / 32);
    constexpr int NITEMS = 2 * I_DUAL + 2 * I_DOWN + I_IN + 3 * I_SQ;
    for (int it = gw; it < NITEMS; it += NGW) {
        int r = it;
        if (r < I_DUAL) {
            const int nblk = 2 * FF / 32, kb = r / nblk, nb = r % nblk, n0 = 32 * nb, j = n0 >> 8, c = n0 & 255;
            p0_item(c < 128 ? a.in[2] : a.in[3], FF, 128 * j + (c & 127), a.in[1], (bf16*)(ws + WS_W1), D, n0, 64 * kb, scr, F.lane); continue; } r -= I_DUAL;
        if (r < I_DOWN) { const int nblk = D / 32, kb = r / nblk, nb = r % nblk;
            p0_item(a.in[4], D, 32 * nb, nullptr, (bf16*)(ws + WS_W2), FF, 32 * nb, 64 * kb, scr, F.lane); continue; } r -= I_DOWN;
        if (r < I_IN) { const int nblk = INW / 32, kb = r / nblk, nb = r % nblk, n0 = 32 * nb; int sc = n0;
            if (n0 >= 8192 && n0 < 12288) { const int t = n0 - 8192, j = t >> 8, c = t & 255; sc = c < 128 ? 8192 + 128 * j + c : 10240 + 128 * j + (c - 128); }
            p0_item(a.in[6], INW, sc, a.in[5], (bf16*)(ws + WS_WIN), D, n0, 64 * kb, scr, F.lane); continue; } r -= I_IN;
        if (r < 3 * I_SQ) { const int w = r / I_SQ, q = r % I_SQ, nblk = D / 32, kb = q / nblk, nb = q % nblk;
            p0_item(a.in[9 + w], D, 32 * nb, nullptr, (bf16*)(ws + WS_WA + (size_t)w * 8 * MiB), D, 32 * nb, 64 * kb, scr, F.lane); continue; } r -= 3 * I_SQ;
        if (r < I_DUAL) { const int nblk = 2 * FF / 32, kb = r / nblk, nb = r % nblk, n0 = 32 * nb, j = n0 >> 8, c = n0 & 255;
            p0_item(c < 128 ? a.in[13] : a.in[14], FF, 128 * j + (c & 127), a.in[12], (bf16*)(ws + WS_W3), D, n0, 64 * kb, scr, F.lane); continue; } r -= I_DUAL;
        { const int nblk = D / 32, kb = r / nblk, nb = r % nblk;
            p0_item(a.in[15], D, 32 * nb, nullptr, (bf16*)(ws + WS_W4), FF, 32 * nb, 64 * kb, scr, F.lane); }
    }
    const float* x = a.in[0]; bf16* XB = (bf16*)(ws + WS_XB); float* ss1 = (float*)(ws + WS_CTL) + CW_SS1;
    for (int m = gw; m < M; m += NGW) {
        const GAS f32x4* xr = (const GAS f32x4*)(x + (size_t)m * D) + F.lane; GAS unsigned long long* o8 = (GAS unsigned long long*)(XB + (size_t)m * D) + F.lane; float s = 0.f;
#pragma unroll
        for (int j = 0; j < 8; ++j) { const f32x4 v = xr[64 * j]; s += (v.x * v.x + v.y * v.y) + (v.z * v.z + v.w * v.w);
            o8[64 * j] = (unsigned long long)pk2(v.x, v.y) | ((unsigned long long)pk2(v.z, v.w) << 32); }
        s = wave_sum(s); if (F.lane == 0) ss1[m] = s;
    }
}

__device__ __forceinline__ void p4_conv(Frame& F, const Args& a) {
    const int ch = (F.tid & 255) * 8, row0 = 32 * F.vcu + 16 * (F.tid >> 8);
    const bf16* U = (const bf16*)(a.ws + WS_U); bf16* GBp = (bf16*)(a.ws + WS_GB); const float* cw = a.in[8];
    float w0[8], w1[8], w2[8];
#pragma unroll
    for (int e = 0; e < 8; ++e) { w0[e] = cw[ch + e]; w1[e] = cw[D + ch + e]; w2[e] = cw[2 * D + ch + e]; }
    float um1[8], um2[8];
    const bool first = (row0 & (S - 1)) == 0;
    { v4u a1 = (v4u){0u, 0u, 0u, 0u}, a2 = a1;
      if (!first) { a1 = *(const GAS v4u*)(U + (size_t)(row0 - 1) * D + ch); a2 = *(const GAS v4u*)(U + (size_t)(row0 - 2) * D + ch); }
#pragma unroll
      for (int e = 0; e < 4; ++e) { um1[2 * e] = __builtin_bit_cast(float, a1[e] << 16); um1[2 * e + 1] = __builtin_bit_cast(float, a1[e] & 0xffff0000u);
                                    um2[2 * e] = __builtin_bit_cast(float, a2[e] << 16); um2[2 * e + 1] = __builtin_bit_cast(float, a2[e] & 0xffff0000u); } }
#pragma unroll 4
    for (int i = 0; i < 16; ++i) { const size_t off = (size_t)(row0 + i) * D + ch;
        const v4u uu = *(const GAS v4u*)(U + off), gg = *(const GAS v4u*)(GBp + off); float u[8], g[8], c[8];
#pragma unroll
        for (int e = 0; e < 4; ++e) { u[2 * e] = __builtin_bit_cast(float, uu[e] << 16); u[2 * e + 1] = __builtin_bit_cast(float, uu[e] & 0xffff0000u);
                                      g[2 * e] = __builtin_bit_cast(float, gg[e] << 16); g[2 * e + 1] = __builtin_bit_cast(float, gg[e] & 0xffff0000u); }
#pragma unroll
        for (int e = 0; e < 8; ++e) { c[e] = g[e] * (w0[e] * um2[e] + w1[e] * um1[e] + w2[e] * u[e]); um2[e] = um1[e]; um1[e] = u[e]; }
        v4u o; o.x = pk2(c[0], c[1]); o.y = pk2(c[2], c[3]); o.z = pk2(c[4], c[5]); o.w = pk2(c[6], c[7]);
        *(GAS v4u*)(GBp + off) = o; }
}
__device__ __forceinline__ void p4_attention(Frame& F, const Args& a, char* lds) {
    typedef attn::bf16 ab16; typedef attn::BlockRef<ab16, ab16> Ref;
    const int bh = F.vcu >> 2, p = F.vcu & 3, b = bh >> 4, h = bh & 15;
    const ab16* Q = (const ab16*)(a.ws + WS_Q) + (size_t)bh * S * HD; const ab16* K = (const ab16*)(a.ws + WS_K) + (size_t)bh * S * HD; const ab16* V = (const ab16*)(a.ws + WS_V) + (size_t)bh * S * HD;
    ab16* O = (ab16*)(a.ws + WS_O) + (size_t)b * S * D + h * HD;
    const float* km = (const float*)(a.ws + WS_CTL) + CW_KPART + (size_t)(b * 8 * 2) * D + h * HD;
    const float Aal = __builtin_amdgcn_exp2f(-0.5f * (float)(h + 1)) * 11.313708498984761f;
    Ref r0, r1;
    r0.Q = Q + (size_t)(p * 256) * HD; r0.K = K; r0.V = V; r0.O = O + (size_t)(p * 256) * D; r0.P0 = p * 256; r0.km = km; r0.Aal = Aal;
    r1.Q = Q + (size_t)((7 - p) * 256) * HD; r1.K = K; r1.V = V; r1.O = O + (size_t)((7 - p) * 256) * D; r1.P0 = (7 - p) * 256; r1.km = km; r1.Aal = Aal;
    attn::Seam<ab16> Sm;
    attn::causal_swa_prime<ab16, ab16>(r0, 0x7fffffff, lds, Sm);
    Ref cur = r0;
#pragma nounroll
    for (int i = 0; i < 2; ++i) { attn::causal_swa_block<ab16, ab16>(cur, r1, S, 0x7fffffff, lds, Sm); cur = r1; }
}
__device__ __forceinline__ void p9_final(Frame& F, const Args& a) {
    const int gw = F.vcu * NWAVES + F.wave, NGW = F.G * NWAVES;
    const float* ss4 = (const float*)(a.ws + WS_CTL) + CW_SS4; const float* gf = a.in[16];
    for (int m = gw; m < M; m += NGW) { const float r = __builtin_amdgcn_rsqf(ss4[m] * (1.0f / D) + EPS);
        GAS f32x4* xr = (GAS f32x4*)(a.out + (size_t)m * D) + F.lane; const GAS f32x4* gr = (const GAS f32x4*)gf + F.lane;
#pragma unroll
        for (int j = 0; j < 8; ++j) { f32x4 v = xr[64 * j]; const f32x4 g = gr[64 * j]; xr[64 * j] = v * r * g; } }
}

__global__ void __launch_bounds__(NWAVES * 64, 2) mk_fwd(Args args) {
    extern __shared__ __attribute__((aligned(16))) unsigned char lds[];
    Frame F;
    F.lds = (LAS unsigned char*)lds;
    F.MISC = (volatile LAS unsigned*)(F.lds + MISC_OFF);
    F.tid = threadIdx.x; F.lane = F.tid & 63; F.wave = __builtin_amdgcn_readfirstlane(F.tid >> 6);
    F.G = gridDim.x; { const int bx = blockIdx.x; F.vcu = (F.G % 8 == 0) ? (bx % 8) * (F.G / 8) + bx / 8 : bx; }
    unsigned char* ws = args.ws;
    F.ctl = (gu32*)(ws + WS_CTL);
    for (int u = F.tid; u < (LDS_BYTES - LDSCTL_OFF) / 4; u += NWAVES * 64) ((LAS unsigned*)(F.lds + LDSCTL_OFF))[u] = 0u;
    __syncthreads();
    XcdBarrier bar = xcd_barrier_post((unsigned*)(F.ctl + CW_BAR) + args.li * XCD_BAR_WORDS, F.MISC + 8);
#define GRID_BAR() xcd_barrier(bar)
    const int lo = args.ph_lo, hi = args.ph_hi;
#ifndef PH_MASK
#define PH_MASK 0x3ff
#endif
#define IN(k) (((PH_MASK >> (k)) & 1) && lo <= (k) && (k) < hi)
#define BOTH(k) (IN(k) && IN((k) + 1))
    typedef pg8::bf16_t b16;
    float* ctlf = (float*)(ws + WS_CTL);
    b16* XB = (b16*)(ws + WS_XB); b16* H = (b16*)(ws + WS_H);
    const int G = F.G, bx = (int)blockIdx.x;
    constexpr int NOSPLIT = 1 << 30;

    if (IN(0)) { p0_prologue(F, args); if (BOTH(0)) GRID_BAR(); }
    if (IN(1)) {
        pg8::Gemm g{XB, (const b16*)(ws + WS_W1), M, 2 * FF, D, nullptr, NOSPLIT}; pg8::StaticOrder S; S.init(M, 2 * FF, G, bx);
        pg8::EpiSwiglu E{H, ctlf + CW_SS1};
        pg8::gemm_phase<pg8::EpiSwiglu, pg8::StaticOrder, true, true>(F.lds + RING_OFF, g, S, E);
        if (BOTH(1)) GRID_BAR();
    }
    if (IN(2)) {
        pg8::Gemm g{H, (const b16*)(ws + WS_W2), M, D, FF, nullptr, NOSPLIT}; pg8::StaticOrder S; S.init(M, D, G, bx);
        pg8::EpiResid E{args.in[0], args.out, XB, ctlf + CW_SS2, 0.5f, 0};
        pg8::gemm_phase<pg8::EpiResid, pg8::StaticOrder, true, true>(F.lds + RING_OFF, g, S, E);
        if (BOTH(2)) GRID_BAR();
    }
    if (IN(3)) {
        pg8::Gemm g{XB, (const b16*)(ws + WS_WIN), M, INW, D, nullptr, NOSPLIT}; pg8::StaticOrder S; S.init(M, INW, G, bx);
        pg8::EpiIn E{(b16*)(ws + WS_Q), (b16*)(ws + WS_GB), (b16*)(ws + WS_U), (b16*)(ws + WS_GA), ctlf + CW_SS2, args.in[7], ctlf + CW_KPART};
        pg8::gemm_phase<pg8::EpiIn, pg8::StaticOrder, true, true>(F.lds + RING_OFF, g, S, E);
        if (BOTH(3)) GRID_BAR();
    }
    if (IN(4)) {
        if (F.G == 256) { p4_conv(F, args); p4_attention(F, args, (char*)lds); }
        if (BOTH(4)) GRID_BAR();
    }
    if (IN(5)) {
        pg8::Gemm g{(const b16*)(ws + WS_O), (const b16*)(ws + WS_WA), M, 2 * D, D, (const b16*)(ws + WS_GB), 8}; pg8::PairOrder S; S.so.init(M, D, G, bx);
        pg8::EpiMix E{(float*)(ws + WS_T), (const b16*)(ws + WS_GA), (const b16*)(ws + WS_GC), (b16*)(ws + WS_M)};
        pg8::gemm_phase<pg8::EpiMix, pg8::PairOrder, true, true>(F.lds + RING_OFF, g, S, E);
        if (BOTH(5)) GRID_BAR();
    }
    if (IN(6)) {
        pg8::Gemm g{(const b16*)(ws + WS_M), (const b16*)(ws + WS_WO), M, D, D, nullptr, NOSPLIT}; pg8::StaticOrder S; S.init(M, D, G, bx);
        pg8::EpiResid E{args.out, args.out, XB, ctlf + CW_SS3, 1.0f, 0};
        pg8::gemm_phase<pg8::EpiResid, pg8::StaticOrder, true, true>(F.lds + RING_OFF, g, S, E);
        if (BOTH(6)) GRID_BAR();
    }
    if (IN(7)) {
        pg8::Gemm g{XB, (const b16*)(ws + WS_W3), M, 2 * FF, D, nullptr, NOSPLIT}; pg8::StaticOrder S; S.init(M, 2 * FF, G, bx);
        pg8::EpiSwiglu E{H, ctlf + CW_SS3};
        pg8::gemm_phase<pg8::EpiSwiglu, pg8::StaticOrder, true, true>(F.lds + RING_OFF, g, S, E);
        if (BOTH(7)) GRID_BAR();
    }
    if (IN(8)) {
        pg8::Gemm g{H, (const b16*)(ws + WS_W4), M, D, FF, nullptr, NOSPLIT}; pg8::StaticOrder S; S.init(M, D, G, bx);
        pg8::EpiResid E{args.out, args.out, nullptr, ctlf + CW_SS4, 0.5f, 0};
        pg8::gemm_phase<pg8::EpiResid, pg8::StaticOrder, true, true>(F.lds + RING_OFF, g, S, E);
        if (BOTH(8)) GRID_BAR();
    }
    if (IN(9)) p9_final(F, args);
#undef IN
#undef BOTH
}

typedef unsigned short bf16_t;
__device__ __forceinline__ unsigned f2bf_s(float f) { unsigned u = __builtin_bit_cast(unsigned, f); return (u + 0x7fffu + ((u >> 16) & 1u)) >> 16; }
__device__ __forceinline__ float bf2f(bf16_t b) { return __builtin_bit_cast(float, (unsigned)b << 16); }
__global__ __launch_bounds__(256) void km_from_parts(const float* __restrict__ kpart, float* __restrict__ km) {
    const int i = blockIdx.x * 256 + threadIdx.x, pm = i >> 11, c = i & 2047;
    km[i] = (kpart[(size_t)(pm * 2) * D + c] + kpart[(size_t)(pm * 2 + 1) * D + c]) * (1.f / 256.f);
}
__global__ __launch_bounds__(256) void attn_simple(const bf16_t* __restrict__ Q, const bf16_t* __restrict__ Kb, const bf16_t* __restrict__ Vb, const float* __restrict__ km, bf16_t* __restrict__ O) {
    __shared__ float q_s[128], gate_s[8], p_s[1024], red_s[8], acc_s[128];
    __shared__ int blk_s[4], cnt_s;
    const int tid = threadIdx.x, lane = tid & 63, w = tid >> 6;
    const int bh = blockIdx.x >> 11, s = blockIdx.x & 2047, b = bh >> 4, h = bh & 15, own = s >> 8;
    const float slope = exp2f(-0.5f * (float)(h + 1)), scale = 0.08838834764831845f;
    if (tid < 128) q_s[tid] = bf2f(Q[((size_t)bh * S + s) * HD + tid]);
    __syncthreads();
    for (int j = w; j < own; j += 4) { const float* kmp = km + (size_t)(b * 8 + j) * D + h * HD; float p = q_s[lane] * kmp[lane] + q_s[lane + 64] * kmp[lane + 64];
        for (int o = 1; o < 64; o <<= 1) p += __shfl_xor(p, o);
        if (lane == 0) gate_s[j] = p; }
    __syncthreads();
    if (tid == 0) { unsigned mask = 0; if (own <= 3) mask = (1u << own) - 1u; else { for (int it = 0; it < 3; ++it) { int best = -1; float bv = 0.f; for (int j = 0; j < own; ++j) if (!((mask >> j) & 1u) && (best < 0 || gate_s[j] > bv)) { best = j; bv = gate_s[j]; } mask |= 1u << best; } }
        int c = 0; for (int j = 0; j < own; ++j) if ((mask >> j) & 1u) blk_s[c++] = j; blk_s[c++] = own; cnt_s = c; }
    __syncthreads();
    const int cnt = cnt_s; float mx = -INFINITY;
    for (int c = 0; c < cnt; ++c) { const int j = blk_s[c], pos = j * 256 + tid; const bf16_t* kp = Kb + ((size_t)bh * S + pos) * HD; float dot = 0.f;
        for (int d8 = 0; d8 < 16; ++d8) { const bf16x8 kv = *(const bf16x8*)(kp + d8 * 8); for (int e = 0; e < 8; ++e) dot += q_s[d8 * 8 + e] * bf2f((bf16_t)kv[e]); }
        float sc = dot * scale - slope * (float)(s - pos); if (pos > s) sc = -INFINITY; p_s[c * 256 + tid] = sc; mx = fmaxf(mx, sc); }
    for (int o = 1; o < 64; o <<= 1) mx = fmaxf(mx, __shfl_xor(mx, o));
    if (lane == 0) red_s[w] = mx;
    __syncthreads();
    mx = fmaxf(fmaxf(red_s[0], red_s[1]), fmaxf(red_s[2], red_s[3]));
    float sum = 0.f;
    for (int c = 0; c < cnt; ++c) { const float p = __expf(p_s[c * 256 + tid] - mx); p_s[c * 256 + tid] = p; sum += p; }
    for (int o = 1; o < 64; o <<= 1) sum += __shfl_xor(sum, o);
    if (lane == 0) red_s[4 + w] = sum;
    __syncthreads();
    const float l = red_s[4] + red_s[5] + red_s[6] + red_s[7];
    const int d = tid & 127, half = tid >> 7, nk = cnt * 256; float acc = 0.f;
    for (int i = half * (nk / 2); i < (half + 1) * (nk / 2); ++i) { const int pos = blk_s[i >> 8] * 256 + (i & 255); acc += p_s[i] * bf2f(Vb[((size_t)bh * S + pos) * HD + d]); }
    if (half == 1) acc_s[d] = acc;
    __syncthreads();
    if (half == 0) O[((size_t)(b * S + s)) * D + h * HD + d] = (bf16_t)f2bf_s((acc + acc_s[d]) / l);
}
__global__ __launch_bounds__(256) void conv_k(bf16_t* __restrict__ GB, const bf16_t* __restrict__ U, const float* __restrict__ cw) {
    const size_t idx = (size_t)blockIdx.x * 256 + threadIdx.x; const int row = (int)(idx >> 11), ch = (int)(idx & 2047), s = row & 2047;
    float y = cw[2 * D + ch] * bf2f(U[idx]);
    if (s >= 1) y += cw[1 * D + ch] * bf2f(U[idx - D]);
    if (s >= 2) y += cw[0 * D + ch] * bf2f(U[idx - 2 * D]);
    GB[idx] = (bf16_t)f2bf_s(bf2f(GB[idx]) * y);
}

extern "C" void kernel_launch(void* const* d_in, const int* in_sizes, int n_in, void* d_out, int out_size, void* d_ws, size_t ws_size, hipStream_t stream) {
    static int grid = 0;
    if (grid == 0) {
        if (n_in != 17 || in_sizes[0] != M * D || out_size != M * D || ws_size < WS_END) { fprintf(stderr, "kernel_launch: unexpected shapes (n_in %d out %d ws %zu)\n", n_in, out_size, ws_size); grid = -1; return; }
        int dev = 0, cus = 0, per_cu = 0;
        if (hipGetDevice(&dev) != hipSuccess || hipDeviceGetAttribute(&cus, hipDeviceAttributeMultiprocessorCount, dev) != hipSuccess) { grid = -1; return; }
        if (hipFuncSetAttribute((const void*)mk_fwd, hipFuncAttributeMaxDynamicSharedMemorySize, LDS_BYTES) != hipSuccess) { fprintf(stderr, "kernel_launch: hipFuncSetAttribute failed\n"); grid = -1; return; }
        if (hipOccupancyMaxActiveBlocksPerMultiprocessor(&per_cu, (const void*)mk_fwd, NWAVES * 64, LDS_BYTES) != hipSuccess || per_cu < 1) fprintf(stderr, "kernel_launch: occupancy query reports %d\n", per_cu);
        (void)hipGetLastError();
        grid = cus;
    }
    if (grid < 0) return;
    (void)hipMemsetAsync((char*)d_ws + WS_CTL, 0, CTL_ZERO_BYTES, stream);
    Args a{};
    for (int i = 0; i < 17; ++i) a.in[i] = (const float*)d_in[i];
    a.out = (float*)d_out; a.ws = (unsigned char*)d_ws;
    char* ws = (char*)d_ws; float* ctlf = (float*)(ws + WS_CTL);
#if MK_STAGE == 1
    a.ph_lo = 0; a.ph_hi = 4; a.li = 0;
    hipLaunchKernelGGL(mk_fwd, dim3(grid), dim3(NWAVES * 64), LDS_BYTES, stream, a);
    km_from_parts<<<32 * 2048 / 256, 256, 0, stream>>>(ctlf + CW_KPART, ctlf + CW_KM);
    attn_simple<<<NB * NH * S, 256, 0, stream>>>((const bf16_t*)(ws + WS_Q), (const bf16_t*)(ws + WS_K), (const bf16_t*)(ws + WS_V), ctlf + CW_KM, (bf16_t*)(ws + WS_O));
    conv_k<<<M * D / 256, 256, 0, stream>>>((bf16_t*)(ws + WS_GB), (const bf16_t*)(ws + WS_U), (const float*)d_in[8]);
    a.ph_lo = 5; a.ph_hi = 10; a.li = 1;
    hipLaunchKernelGGL(mk_fwd, dim3(grid), dim3(NWAVES * 64), LDS_BYTES, stream, a);
#else
    a.ph_lo = 0; a.ph_hi = 10; a.li = 0;
    hipLaunchKernelGGL(mk_fwd, dim3(grid), dim3(NWAVES * 64), LDS_BYTES, stream, a);
#endif
}
```

```cpp
#include <hip/hip_runtime.h>
#include <cstdio>
#include <cstdint>


constexpr int NB = 4, S = 2048, D = 2048, NH = 16, HD = 128, FF = 5632, M = NB * S, INW = 16384;
constexpr float EPS = 1e-6f;
#define MK_STAGE 2
#define MK_PROBE_PHASE 0
#define MK_PROBE_REP 0
namespace pg8 {
#define PG8_LAS __attribute__((address_space(3)))
typedef unsigned short bf16_t;
typedef short bf16x8 __attribute__((ext_vector_type(8)));
typedef float f32x4 __attribute__((ext_vector_type(4)));
typedef unsigned u32x4 __attribute__((ext_vector_type(4)));
typedef unsigned u32x2 __attribute__((ext_vector_type(2)));
constexpr int BM = 256, BK = 64, HALF = 128, HTB = HALF * BK * 2  , STAGE_BYTES = 8 * HTB, NXCD = 8, WGM = 8;

__host__ __device__ __forceinline__ int lds_byte(int r, int c) { const int st = (r >> 4) * 2 + (c >> 5), rr = r & 15, cc = c & 31, ob = rr * 64 + cc * 2; return st * 1024 + (ob ^ (((ob >> 9) & 1) << 5)); }
__host__ __device__ __forceinline__ void stage_rc(int b, int& R, int& C) { const int st = b / 1024, sb = b % 1024, swz = sb ^ (((sb >> 9) & 1) << 5); R = (st >> 1) * 16 + swz / 64; C = (st & 1) * 32 + (swz % 64) / 2; }
__host__ __device__ __forceinline__ int perm32(int rho) { const int n = rho >> 4, i = rho & 15; return 8 * (i >> 2) + 4 * n + (i & 3); }

struct Unit { int pm, pn; };
struct Gemm { const bf16_t* A; const bf16_t* Bt; int M, N, K; const bf16_t* A2; int pn_split; };

struct StaticOrder {
    int nM, nN, nwg, G, c;
    __host__ __device__ void init(int M, int N, int G_, int c_) { nM = M / BM; nN = N / BM; nwg = nM * nN; G = G_; c = c_; }
    __host__ __device__ bool next(int i, Unit& u) const {
        const long L = (long)i * G + c; if (L >= nwg) return false;
        int wgid = (int)L; { const int q = nwg / NXCD, r = nwg % NXCD, xcd = wgid % NXCD, off = wgid / NXCD; wgid = (xcd < r ? xcd * (q + 1) : r * (q + 1) + (xcd - r) * q) + off; }
        const int nig = WGM * nN, gid = wgid / nig, fm = gid * WGM, gsz = (nM - fm) < WGM ? (nM - fm) : WGM;
        u.pm = fm + ((wgid % nig) % gsz); u.pn = (wgid % nig) / gsz; return true;
    }
    __device__ __forceinline__ void a_ready(const Unit&) const {}
    __device__ __forceinline__ void done(const Unit&) const {}
};
struct PairOrder {
    StaticOrder so;
    __device__ bool next(int i, Unit& u) const { if (!so.next(i >> 1, u)) return false; if ((i & 1) == 0) u.pn += 8; return true; }
    __device__ __forceinline__ void a_ready(const Unit&) const {}
    __device__ __forceinline__ void done(const Unit&) const {}
};
__device__ __forceinline__ unsigned cvt_pk_bf16(float lo, float hi) { unsigned r; asm volatile("v_cvt_pk_bf16_f32 %0, %1, %2" : "=v"(r) : "v"(lo), "v"(hi)); return r; }
__device__ __forceinline__ float rstd_of(const float* ss, int row) { return __builtin_amdgcn_rsqf(ss[row] * (1.0f / D) + EPS); }
__device__ __forceinline__ f32x4 sigmoid4(f32x4 z) { f32x4 o;
#pragma unroll
    for (int e = 0; e < 4; ++e) o[e] = __builtin_amdgcn_rcpf(1.0f + __builtin_amdgcn_exp2f(-1.4426950408889634f * z[e]));
    return o; }
__device__ __forceinline__ u32x4 pack8(f32x4 a, f32x4 b) { u32x4 w; w.x = cvt_pk_bf16(a[0], a[1]); w.y = cvt_pk_bf16(a[2], a[3]); w.z = cvt_pk_bf16(b[0], b[1]); w.w = cvt_pk_bf16(b[2], b[3]); return w; }
__device__ __forceinline__ void unpack8(u32x4 w, f32x4& a, f32x4& b) {
    a[0] = __builtin_bit_cast(float, w.x << 16); a[1] = __builtin_bit_cast(float, w.x & 0xffff0000u); a[2] = __builtin_bit_cast(float, w.y << 16); a[3] = __builtin_bit_cast(float, w.y & 0xffff0000u);
    b[0] = __builtin_bit_cast(float, w.z << 16); b[1] = __builtin_bit_cast(float, w.z & 0xffff0000u); b[2] = __builtin_bit_cast(float, w.w << 16); b[3] = __builtin_bit_cast(float, w.w & 0xffff0000u); }

struct EpiSwiglu {
    static constexpr bool PERM = true, AFTER_DRAIN = false;
    bf16_t* H; const float* ss;
    __device__ __forceinline__ void operator()(const f32x4 (&acc)[2][2][4][2], const Unit& u, int wr, int wc, int fr, int fq) const {
        const int row0 = u.pm * BM + wr * 64 + fr, col0 = u.pn * HALF + wc * 32 + 8 * fq;
#pragma unroll
        for (int ai = 0; ai < 2; ++ai)
#pragma unroll
            for (int m = 0; m < 4; ++m) { const int row = row0 + ai * HALF + m * 16; const float r = rstd_of(ss, row);
                const f32x4 g0 = acc[ai][0][m][0] * r, g1 = acc[ai][0][m][1] * r, u0 = acc[ai][1][m][0] * r, u1 = acc[ai][1][m][1] * r;
                const f32x4 h0 = g0 * sigmoid4(g0) * u0, h1 = g1 * sigmoid4(g1) * u1;
                *(u32x4*)(H + (size_t)row * FF + col0) = pack8(h0, h1); }
    }
};
struct EpiResid {
    static constexpr bool PERM = true, AFTER_DRAIN = false;
    const float* X0; float* X; bf16_t* XB; float* ss; float scale; int pad;
    __device__ __forceinline__ void operator()(const f32x4 (&acc)[2][2][4][2], const Unit& u, int wr, int wc, int fr, int fq) const {
        const int row0 = u.pm * BM + wr * 64 + fr, col0 = u.pn * BM + wc * 32 + 8 * fq;
#pragma unroll
        for (int ai = 0; ai < 2; ++ai)
#pragma unroll
            for (int m = 0; m < 4; ++m) { const int row = row0 + ai * HALF + m * 16; float sq = 0.f;
#pragma unroll
                for (int bj = 0; bj < 2; ++bj) { const size_t off = (size_t)row * D + col0 + bj * HALF;
                    const f32x4 a = *(const f32x4*)(X0 + off) + acc[ai][bj][m][0] * scale, b = *(const f32x4*)(X0 + off + 4) + acc[ai][bj][m][1] * scale;
                    *(f32x4*)(X + off) = a; *(f32x4*)(X + off + 4) = b;
                    if (XB) *(u32x4*)(XB + off) = pack8(a, b);
                    sq += (a[0] * a[0] + a[1] * a[1]) + (a[2] * a[2] + a[3] * a[3]) + (b[0] * b[0] + b[1] * b[1]) + (b[2] * b[2] + b[3] * b[3]); }
                sq += __shfl_xor(sq, 16); sq += __shfl_xor(sq, 32);
                if (fq == 0) atomicAdd(ss + row, sq); }
    }
};
struct EpiIn {
    static constexpr bool PERM = true, AFTER_DRAIN = false;
    bf16_t* QKV; bf16_t* GB; bf16_t* U; bf16_t* GA; const float* ss; const float* bias; float* kpart;
    __device__ __forceinline__ void operator()(const f32x4 (&acc)[2][2][4][2], const Unit& u, int wr, int wc, int fr, int fq) const {
        const int row0 = u.pm * BM + wr * 64 + fr, cw = wc * 32 + 8 * fq; const int pn = u.pn;
        if (pn < 24) {
            const int t = pn >> 3, hb = 2 * (pn & 7); bf16_t* base = QKV + (size_t)t * ((size_t)M * D);
            const bool isk = (t == 1); f32x4 cs[2][2];
#pragma unroll
            for (int bj = 0; bj < 2; ++bj) { cs[bj][0] = (f32x4){0.f, 0.f, 0.f, 0.f}; cs[bj][1] = (f32x4){0.f, 0.f, 0.f, 0.f}; }
#pragma unroll
            for (int ai = 0; ai < 2; ++ai)
#pragma unroll
                for (int m = 0; m < 4; ++m) { const int row = row0 + ai * HALF + m * 16; const float r = rstd_of(ss, row); const int b = row >> 11, s = row & 2047;
#pragma unroll
                    for (int bj = 0; bj < 2; ++bj) { const f32x4 a = acc[ai][bj][m][0] * r, c = acc[ai][bj][m][1] * r;
                        *(u32x4*)(base + ((size_t)((b * NH + hb + bj) * S + s)) * HD + cw) = pack8(a, c);
                        if (isk) { cs[bj][0] += a; cs[bj][1] += c; } } }
            if (isk) {
#pragma unroll
                for (int bj = 0; bj < 2; ++bj)
#pragma unroll
                    for (int n = 0; n < 2; ++n)
#pragma unroll
                        for (int e = 0; e < 4; ++e) { float v = cs[bj][n][e]; v += __shfl_xor(v, 1); v += __shfl_xor(v, 2); v += __shfl_xor(v, 4); v += __shfl_xor(v, 8); cs[bj][n][e] = v; }
                if (fr == 0) {
#pragma unroll
                    for (int bj = 0; bj < 2; ++bj) { float* kp = kpart + (size_t)(u.pm * 2 + wr) * D + (pn - 8) * BM + bj * HALF + cw; *(f32x4*)kp = cs[bj][0]; *(f32x4*)(kp + 4) = cs[bj][1]; } }
            }
        } else if (pn < 32) {
            const int col0 = (pn - 24) * BM + cw;
#pragma unroll
            for (int ai = 0; ai < 2; ++ai)
#pragma unroll
                for (int m = 0; m < 4; ++m) { const int row = row0 + ai * HALF + m * 16; const float r = rstd_of(ss, row);
#pragma unroll
                    for (int bj = 0; bj < 2; ++bj) *(u32x4*)(GB + (size_t)row * D + col0 + bj * HALF) = pack8(acc[ai][bj][m][0] * r, acc[ai][bj][m][1] * r); }
        } else if (pn < 48) {
            const int col0 = (pn - 32) * HALF + cw;
#pragma unroll
            for (int ai = 0; ai < 2; ++ai)
#pragma unroll
                for (int m = 0; m < 4; ++m) { const int row = row0 + ai * HALF + m * 16; const float r = rstd_of(ss, row), r2 = r * r;
                    *(u32x4*)(U + (size_t)row * D + col0) = pack8(acc[ai][0][m][0] * acc[ai][1][m][0] * r2, acc[ai][0][m][1] * acc[ai][1][m][1] * r2); }
        } else {
            const int t = (pn - 48) >> 3, col0 = ((pn - 48) & 7) * BM + cw; bf16_t* base = GA + (size_t)t * ((size_t)M * D); const float* bp = bias + (pn - 48) * BM + cw;
            f32x4 bv[2][2];
#pragma unroll
            for (int bj = 0; bj < 2; ++bj) { bv[bj][0] = *(const f32x4*)(bp + bj * HALF); bv[bj][1] = *(const f32x4*)(bp + bj * HALF + 4); }
#pragma unroll
            for (int ai = 0; ai < 2; ++ai)
#pragma unroll
                for (int m = 0; m < 4; ++m) { const int row = row0 + ai * HALF + m * 16; const float r = rstd_of(ss, row);
#pragma unroll
                    for (int bj = 0; bj < 2; ++bj) *(u32x4*)(base + (size_t)row * D + col0 + bj * HALF) = pack8(sigmoid4(acc[ai][bj][m][0] * r + bv[bj][0]), sigmoid4(acc[ai][bj][m][1] * r + bv[bj][1])); }
        }
    }
};
struct EpiMix {
    static constexpr bool PERM = true, AFTER_DRAIN = false;
    float* T; const bf16_t* GA; const bf16_t* GC; bf16_t* Mo;
    __device__ __forceinline__ void operator()(const f32x4 (&acc)[2][2][4][2], const Unit& u, int wr, int wc, int fr, int fq) const {
        const bool conv = u.pn >= 8; const int pn = u.pn & 7;
        const int row0 = u.pm * BM + wr * 64 + fr, col0 = pn * BM + wc * 32 + 8 * fq;
        typedef __attribute__((address_space(1))) char gchar; typedef __attribute__((address_space(1))) f32x4 gf4; typedef __attribute__((address_space(1))) u32x4 gu4;
        gchar* tp = (gchar*)T + ((size_t)blockIdx.x * (8 * 512) + threadIdx.x) * 64;
        const size_t off0 = ((size_t)row0 * D + col0) * 2;
        const gchar* gp = (const gchar*)(conv ? GC : GA) + off0; gchar* mp = (gchar*)Mo + off0;
#pragma unroll
        for (int ai = 0; ai < 2; ++ai) {
#pragma unroll
            for (int m = 0; m < 4; ++m) {
#pragma unroll
                for (int bj = 0; bj < 2; ++bj) {
                    f32x4 g0, g1; unpack8(*(const gu4*)(gp + bj * (HALF * 2)), g0, g1);
                    if (conv) { *(gf4*)(tp + bj * 32) = acc[ai][bj][m][0] * g0; *(gf4*)(tp + bj * 32 + 16) = acc[ai][bj][m][1] * g1; }
                    else { const f32x4 t0 = *(const gf4*)(tp + bj * 32), t1 = *(const gf4*)(tp + bj * 32 + 16);
                        *(gu4*)(mp + bj * (HALF * 2)) = pack8(acc[ai][bj][m][0] * g0 + t0, acc[ai][bj][m][1] * g1 + t1); } }
                const size_t rstep = (m == 3 ? (size_t)(HALF - 48) : (size_t)16) * D * 2;
                gp += rstep; mp += rstep; tp += 512 * 64;
                asm volatile("" : "+v"(gp), "+v"(mp), "+v"(tp)); } }
    }
};
template <class Epi, class Sched, bool ALIGN_EPI = false, bool SP2 = false>
__device__ __forceinline__ void gemm_phase(PG8_LAS unsigned char* lds, const Gemm g, const Sched& S, const Epi& E) {
    const int tid = threadIdx.x, wid = __builtin_amdgcn_readfirstlane(tid >> 6), lane = tid & 63, wr = wid >> 2, wc = wid & 3, fr = lane & 15, fq = lane >> 4;
    const int K = g.K, nt = K / BK;
    unsigned voffA[2], voffB[2];
#pragma unroll
    for (int i = 0; i < 2; ++i) { int R, C; stage_rc(tid * 16 + i * 8192, R, C); const int Rb = Epi::PERM ? ((R & ~31) + perm32(R & 31)) : R;
        voffA[i] = (unsigned)(R * K + C) * 2u; voffB[i] = (unsigned)(Rb * K + C) * 2u; }
    const size_t kstep = (size_t)(BK * 2);
    const size_t hstep = (size_t)HALF * K * 2;
    const size_t tstep = 2 * hstep;
    const unsigned ldsw = (unsigned)wid * 1024u;
    const int aoff = lds_byte(wr * 64 + fr, fq * 8), boff = lds_byte(wc * 32 + fr, fq * 8);
#define PG8_SA(b, h) (((b) * 2 + (h)) * HTB)
#define PG8_SB(b, h) ((4 + (b) * 2 + (h)) * HTB)
#define PG8_STAGE(bufoff, gbase, voff) do { _Pragma("unroll") for (int _i = 0; _i < 2; ++_i) \
        __builtin_amdgcn_global_load_lds((const unsigned*)((const char*)(gbase) + (voff)[_i]), (PG8_LAS unsigned*)(lds + (bufoff) + ldsw + _i * 8192), 16, 0, 0); } while (0)
#define PG8_LDA(dst, b, h) do { _Pragma("unroll") for (int m = 0; m < 4; ++m) _Pragma("unroll") for (int k = 0; k < 2; ++k) dst[m][k] = *(const PG8_LAS bf16x8*)(lds + PG8_SA(b, h) + aoff + m * 2048 + k * 1024); } while (0)
#define PG8_LDB(dst, b, h) do { _Pragma("unroll") for (int n = 0; n < 2; ++n) _Pragma("unroll") for (int k = 0; k < 2; ++k) dst[n][k] = *(const PG8_LAS bf16x8*)(lds + PG8_SB(b, h) + boff + n * 2048 + k * 1024); } while (0)
#define PG8_MMA(ai, bj, At, Bt) do { __builtin_amdgcn_s_setprio(1); _Pragma("unroll") for (int m = 0; m < 4; ++m) _Pragma("unroll") for (int n = 0; n < 2; ++n) _Pragma("unroll") for (int k = 0; k < 2; ++k) \
        acc[ai][bj][m][n] = __builtin_amdgcn_mfma_f32_16x16x32_bf16(Bt[n][k], At[m][k], acc[ai][bj][m][n], 0, 0, 0); __builtin_amdgcn_s_setprio(0); } while (0)
#define PG8_WAIT_V(n) asm volatile("s_waitcnt vmcnt(" #n ")" ::: "memory")
#define PG8_WAIT_L(n) asm volatile("s_waitcnt lgkmcnt(" #n ")" ::: "memory")
#define PG8_BAR __builtin_amdgcn_s_barrier()
#define PG8_SCHED __builtin_amdgcn_sched_barrier(0)
    Unit cur, nxt; int ui = 0;
    if (!S.next(0, cur)) return;
    f32x4 acc[2][2][4][2];
#pragma unroll
    for (int a = 0; a < 2; ++a)
#pragma unroll
        for (int b = 0; b < 2; ++b)
#pragma unroll
            for (int m = 0; m < 4; ++m)
#pragma unroll
                for (int n = 0; n < 2; ++n) acc[a][b][m][n] = (f32x4){0.f, 0.f, 0.f, 0.f};
    bf16x8 At[4][2], B0[2][2], B1[2][2];
    const char* cA = (const char*)(cur.pn >= g.pn_split ? g.A2 : g.A) + (size_t)cur.pm * tstep; const char* cB = (const char*)g.Bt + (size_t)cur.pn * tstep;
    S.a_ready(cur);
    if constexpr (SP2) {
        PG8_STAGE(PG8_SB(0, 0), cB, voffB); PG8_STAGE(PG8_SB(0, 1), cB + hstep, voffB); PG8_STAGE(PG8_SA(0, 0), cA, voffA); PG8_STAGE(PG8_SA(0, 1), cA + hstep, voffA);
        if (wr == 1) PG8_BAR;
        PG8_WAIT_V(2); PG8_BAR;
        PG8_STAGE(PG8_SB(1, 0), cB + kstep, voffB); PG8_STAGE(PG8_SA(1, 0), cA + kstep, voffA); PG8_STAGE(PG8_SB(1, 1), cB + hstep + kstep, voffB);
        PG8_WAIT_V(6); PG8_BAR;
    } else {
        PG8_STAGE(PG8_SB(0, 0), cB, voffB); PG8_STAGE(PG8_SA(0, 0), cA, voffA); PG8_STAGE(PG8_SB(0, 1), cB + hstep, voffB); PG8_STAGE(PG8_SA(0, 1), cA + hstep, voffA);
        if (wr == 1) PG8_BAR;
        PG8_WAIT_V(4); PG8_BAR;
        PG8_STAGE(PG8_SB(1, 0), cB + kstep, voffB); PG8_STAGE(PG8_SA(1, 0), cA + kstep, voffA); PG8_STAGE(PG8_SB(1, 1), cB + hstep + kstep, voffB);
        PG8_WAIT_V(6); PG8_BAR;
    }
    for (;;) {
        const bool has_next = S.next(ui + 1, nxt);
        const char* nA = has_next ? (const char*)(nxt.pn >= g.pn_split ? g.A2 : g.A) + (size_t)nxt.pm * tstep : cA; const char* nB = has_next ? (const char*)g.Bt + (size_t)nxt.pn * tstep : cB;
        for (int t = 0; t < nt; t += 2) {
            const bool last = (t == nt - 2);
            const char* a1 = cA + (size_t)(t + 1) * kstep;
            const char* a2 = last ? nA : cA + (size_t)(t + 2) * kstep; const char* b2 = last ? nB : cB + (size_t)(t + 2) * kstep;
            const char* a3 = a2 + kstep; const char* b3 = b2 + kstep;
            if (last && has_next) S.a_ready(nxt);
            if constexpr (SP2) {
            PG8_LDB(B0, 0, 0); PG8_LDB(B1, 0, 1); PG8_SCHED; PG8_LDA(At, 0, 0); PG8_STAGE(PG8_SA(1, 1), a1 + hstep, voffA);
            PG8_WAIT_V(8); PG8_WAIT_L(0); PG8_BAR; PG8_MMA(0, 0, At, B0); PG8_MMA(0, 1, At, B1); PG8_BAR; PG8_SCHED;
            PG8_LDA(At, 0, 1); PG8_STAGE(PG8_SB(0, 0), b2, voffB); PG8_STAGE(PG8_SB(0, 1), b2 + hstep, voffB); PG8_STAGE(PG8_SA(0, 0), a2, voffA);
            PG8_WAIT_V(8); PG8_WAIT_L(0); PG8_BAR; PG8_MMA(1, 0, At, B0); PG8_MMA(1, 1, At, B1); PG8_BAR; PG8_SCHED;
            PG8_LDB(B0, 1, 0); PG8_LDB(B1, 1, 1); PG8_SCHED; PG8_LDA(At, 1, 0); PG8_STAGE(PG8_SA(0, 1), a2 + hstep, voffA);
            PG8_WAIT_V(8); PG8_WAIT_L(0); PG8_BAR; PG8_MMA(0, 0, At, B0); PG8_MMA(0, 1, At, B1); PG8_BAR; PG8_SCHED;
            PG8_LDA(At, 1, 1); PG8_STAGE(PG8_SB(1, 0), b3, voffB); PG8_STAGE(PG8_SB(1, 1), b3 + hstep, voffB); PG8_STAGE(PG8_SA(1, 0), a3, voffA);
            PG8_WAIT_V(8); PG8_WAIT_L(0); PG8_BAR; PG8_MMA(1, 0, At, B0); PG8_MMA(1, 1, At, B1); PG8_BAR; PG8_SCHED;
            } else {
            PG8_LDB(B0, 0, 0); PG8_SCHED; PG8_LDA(At, 0, 0); PG8_STAGE(PG8_SA(1, 1), a1 + hstep, voffA);
            PG8_WAIT_L(8); PG8_BAR; PG8_WAIT_L(0); PG8_MMA(0, 0, At, B0); PG8_BAR; PG8_SCHED;
            PG8_LDB(B1, 0, 1); PG8_STAGE(PG8_SB(0, 0), b2, voffB);
            PG8_BAR; PG8_WAIT_L(0); PG8_MMA(0, 1, At, B1); PG8_BAR;
            PG8_LDA(At, 0, 1); PG8_STAGE(PG8_SA(0, 0), a2, voffA);
            PG8_BAR; PG8_WAIT_L(0); PG8_MMA(1, 0, At, B0); PG8_BAR; PG8_SCHED;
            PG8_STAGE(PG8_SB(0, 1), b2 + hstep, voffB);
            PG8_WAIT_V(6); PG8_BAR; PG8_MMA(1, 1, At, B1); PG8_BAR;
            PG8_LDB(B0, 1, 0); PG8_SCHED; PG8_LDA(At, 1, 0); PG8_STAGE(PG8_SA(0, 1), a2 + hstep, voffA);
            PG8_WAIT_L(8); PG8_BAR; PG8_WAIT_L(0); PG8_MMA(0, 0, At, B0); PG8_BAR; PG8_SCHED;
            PG8_LDB(B1, 1, 1); PG8_STAGE(PG8_SB(1, 0), b3, voffB);
            PG8_BAR; PG8_WAIT_L(0); PG8_MMA(0, 1, At, B1); PG8_BAR;
            PG8_LDA(At, 1, 1); PG8_STAGE(PG8_SA(1, 0), a3, voffA);
            PG8_BAR; PG8_WAIT_L(0); PG8_MMA(1, 0, At, B0); PG8_BAR; PG8_SCHED;
            PG8_STAGE(PG8_SB(1, 1), b3 + hstep, voffB);
            PG8_WAIT_V(6); PG8_BAR; PG8_MMA(1, 1, At, B1); PG8_BAR;
            }
        }
        if constexpr (ALIGN_EPI) { if (wr == 0) PG8_BAR; }
        if constexpr (!Epi::AFTER_DRAIN) { E(acc, cur, wr, wc, fr, fq); S.done(cur); }
        if (!has_next) break;
#pragma unroll
        for (int a = 0; a < 2; ++a)
#pragma unroll
            for (int b = 0; b < 2; ++b)
#pragma unroll
                for (int m = 0; m < 4; ++m)
#pragma unroll
                    for (int n = 0; n < 2; ++n) acc[a][b][m][n] = (f32x4){0.f, 0.f, 0.f, 0.f};
        cur = nxt; cA = nA; cB = nB; ++ui;
        if constexpr (ALIGN_EPI) { if (wr == 1) PG8_BAR; }
    }
    PG8_WAIT_V(0);
    if constexpr (!ALIGN_EPI) { if (wr == 0) PG8_BAR; }
    PG8_BAR;
    if constexpr (Epi::AFTER_DRAIN) { E.fused(acc, cur, wr, wc, fr, fq, lds, wid, lane); S.done(cur); }
#undef PG8_SA
#undef PG8_SB
#undef PG8_STAGE
#undef PG8_LDA
#undef PG8_LDB
#undef PG8_MMA
#undef PG8_WAIT_V
#undef PG8_WAIT_L
#undef PG8_BAR
#undef PG8_SCHED
}
}
constexpr int NWAVES = 8;
constexpr size_t MiB = 1u << 20;
constexpr size_t WS_CTL = 0, CTL_ZERO_BYTES = 1 * MiB;
constexpr size_t WS_W1 = 1 * MiB;
constexpr size_t WS_W2 = WS_W1 + 44 * MiB;
constexpr size_t WS_WIN = WS_W2 + 22 * MiB;
constexpr size_t WS_WA = WS_WIN + 64 * MiB;
constexpr size_t WS_WC = WS_WA + 8 * MiB;
constexpr size_t WS_WO = WS_WC + 8 * MiB;
constexpr size_t WS_W3 = WS_WO + 8 * MiB;
constexpr size_t WS_W4 = WS_W3 + 44 * MiB;
constexpr size_t WS_XB = WS_W4 + 22 * MiB;
constexpr size_t WS_Z = WS_XB + 32 * MiB;
constexpr size_t WS_Q = WS_Z, WS_K = WS_Z + 32 * MiB, WS_V = WS_Z + 64 * MiB, WS_GB = WS_Z + 96 * MiB, WS_U = WS_Z + 128 * MiB,
                 WS_GA = WS_Z + 160 * MiB, WS_GC = WS_Z + 192 * MiB;
constexpr size_t WS_H = WS_Z;
constexpr size_t WS_T = WS_K;
constexpr size_t WS_M = WS_U;
constexpr size_t WS_O = WS_Z + 224 * MiB;
constexpr size_t WS_END = WS_O + 32 * MiB;
constexpr int CW_TMO = 0, CW_CODE = 1, CW_BAR = 4096;
constexpr int CW_SS1 = 32768, CW_SS2 = 40960, CW_SS3 = 49152, CW_SS4 = 57344;
constexpr int CW_KM = 65536;
constexpr int CW_KPART = 131072;
constexpr int RING_OFF = 0, RING_BYTES = 131072;
constexpr int ATT_LDS_END = 67584 + 65536;
constexpr int LDSCTL_OFF = ATT_LDS_END, MISC_OFF = LDSCTL_OFF + 320;
constexpr int LDS_BYTES = 147456;
static_assert(MISC_OFF + 128 <= LDS_BYTES, "LDS map");
#define GAS __attribute__((address_space(1)))
#define LAS __attribute__((address_space(3)))
typedef unsigned short bf16;
typedef unsigned v4u __attribute__((ext_vector_type(4)));
typedef float f32x4 __attribute__((ext_vector_type(4)));
typedef short bf16x8 __attribute__((ext_vector_type(8)));
typedef GAS unsigned gu32;
typedef GAS unsigned long long gu64;
#define RLX_AGENT __ATOMIC_RELAXED, __HIP_MEMORY_SCOPE_AGENT
#define LDS_WAIT() asm volatile("s_waitcnt lgkmcnt(0)" ::: "memory")
#define VM_WAIT() asm volatile("s_waitcnt vmcnt(0)" ::: "memory")
__device__ __forceinline__ unsigned long long rt() { return __builtin_amdgcn_s_memrealtime(); }
__device__ __forceinline__ unsigned f2bf(float f) { unsigned u = __builtin_bit_cast(unsigned, f); return (u + 0x7fffu + ((u >> 16) & 1u)) >> 16; }
__device__ __forceinline__ unsigned pk2(float lo, float hi) { return f2bf(lo) | (f2bf(hi) << 16); }

#define XB_TMO      128
#define XB_XCNT(j)  (256  + 64 * (j))
#define XB_XSUB(j)  (1280 + 64 * (j))
#define XB_XGEN(j)  (2304 + 64 * (j))
#define XB_TOP      3328
#define XB_TOPGEN   3392
#define XCD_BAR_WORDS 3456
#define XB_SPIN_CAP (1u << 18)

__device__ __forceinline__ unsigned xb_ld(unsigned* p)              { return __hip_atomic_load(p, __ATOMIC_RELAXED, __HIP_MEMORY_SCOPE_AGENT); }
__device__ __forceinline__ unsigned xb_add(unsigned* p, unsigned v) { return __hip_atomic_fetch_add(p, v, __ATOMIC_RELAXED, __HIP_MEMORY_SCOPE_AGENT); }
__device__ __forceinline__ unsigned xb_xcc_id() { return (unsigned)__builtin_amdgcn_s_getreg((3 << 11) | 20) & 0xFu; }
#define XB_SPIN(cond, bar) do { unsigned _sp = 0; while (cond) { __builtin_amdgcn_s_sleep(1); \
    if ((++_sp & 255u) == 0u) { if (xb_ld(&(bar)[XB_TMO])) break; if (_sp > XB_SPIN_CAP) { atomicAdd(&(bar)[XB_TMO], 1u); break; } } } } while (0)

struct XcdBarrier {
    unsigned* bar; unsigned x;
    volatile LAS unsigned* st;
};

__device__ __forceinline__ XcdBarrier xcd_barrier_post(unsigned* bar, volatile LAS unsigned* st) {
    XcdBarrier b; b.bar = bar; b.x = xb_xcc_id(); b.st = st;
    if (threadIdx.x == 0) (void)xb_add(&bar[XB_XCNT(b.x)], 1u);
    return b;
}
__device__ __forceinline__ void xcd_barrier_complete(unsigned* bar, unsigned x, unsigned& nloc, unsigned& nx) {
    const unsigned G = gridDim.x * gridDim.y * gridDim.z;
    unsigned sum, cnt, mine, sp = 0u;
    for (;;) {
        sum = 0u; cnt = 0u; mine = 0u;
#pragma unroll
        for (unsigned j = 0; j < 16; ++j) { const unsigned c = xb_ld(&bar[XB_XCNT(j)]); sum += c; cnt += (c > 0u) ? 1u : 0u; mine = (j == x) ? c : mine; }
        if (sum == G) break;
        __builtin_amdgcn_s_sleep(1);
        if ((++sp & 255u) == 0u) { if (xb_ld(&bar[XB_TMO])) break; if (sp > XB_SPIN_CAP) { atomicAdd(&bar[XB_TMO], 1u); break; } }
    }
    nloc = mine > 0u ? mine : 1u; nx = cnt > 0u ? cnt : 1u;
}

__device__ __forceinline__ void xcd_barrier(const XcdBarrier& b) {
    asm volatile("s_waitcnt vmcnt(0)" ::: "memory");
    __syncthreads();
    if (threadIdx.x == 0) {
        unsigned* bar = b.bar;
        __builtin_amdgcn_s_waitcnt(0);
        unsigned nloc = b.st[0], nx = b.st[1];
        if (nloc == 0u) { xcd_barrier_complete(bar, b.x, nloc, nx); b.st[0] = nloc; b.st[1] = nx; }
        const unsigned old = xb_add(&bar[XB_XSUB(b.x)], 1u);
        const unsigned gen = old / nloc;
        if (old + 1u == (gen + 1u) * nloc) {
            __builtin_amdgcn_fence(__ATOMIC_RELEASE, "agent");
            asm volatile("s_waitcnt vmcnt(0)" ::: "memory");
            const unsigned og = xb_add(&bar[XB_TOP], 1u);
            const unsigned tg = og / nx;
            if (og + 1u == (tg + 1u) * nx) xb_add(&bar[XB_TOPGEN], 1u);
            else XB_SPIN(xb_ld(&bar[XB_TOPGEN]) == tg, bar);
            __builtin_amdgcn_fence(__ATOMIC_ACQUIRE, "agent");
            xb_add(&bar[XB_XGEN(b.x)], 1u);
            asm volatile("s_waitcnt vmcnt(0)" ::: "memory");
        } else {
            XB_SPIN(xb_ld(&bar[XB_XGEN(b.x)]) == gen, bar);
            __builtin_amdgcn_fence(__ATOMIC_ACQUIRE, "agent");
            asm volatile("s_waitcnt vmcnt(0)" ::: "memory");
        }
    }
    __syncthreads();
}

namespace attn {
constexpr int D = 128, OSTR = 2048;
constexpr float THR = 8.f;
constexpr float SCALE = 0.08838834764831845f;
constexpr int NW = 8, QBLK = 32, KVBLK = 64, QB = NW * QBLK;
constexpr int SHM_V = KVBLK * D * 2, SHM_K = KVBLK * D * 2;
constexpr int LDS_BYTES = 2 * SHM_V + 2 * SHM_K + NW * 64 * 4;


typedef unsigned short bf16;
typedef short bf16x8 __attribute__((ext_vector_type(8)));
typedef short s16x4 __attribute__((ext_vector_type(4)));
typedef float f32x16 __attribute__((ext_vector_type(16)));
typedef float f32x4 __attribute__((ext_vector_type(4)));
typedef unsigned u32x4 __attribute__((ext_vector_type(4)));
template <class A, class Bt> struct same_t { static constexpr bool v = false; };
template <class A> struct same_t<A, A> { static constexpr bool v = true; };

#define KSWZ(row, colB) ((row) * 256 + ((colB) ^ (((row) & 7) << 4)))
#define SBAR() __builtin_amdgcn_sched_barrier(0)
__device__ __forceinline__ int v_st(int k, int c) { const int kk = (k & ~0xC) | ((k & 4) << 1) | ((k & 8) >> 1); return ((kk >> 3) * 4 + (c >> 5)) * 512 + ((kk & 7) * 32 + (c & 31)) * 2; }
__device__ __forceinline__ int v_rd_base(int lane) { return ((lane & 3) << 3) | (((lane >> 2) & 3) << 6) | (((lane >> 4) & 1) << 5) | (((lane >> 5) & 1) << 8); }
constexpr int v_rd_off(int d0, int ks, int half) { return d0 * 512 + ks * 4096 + half * 2048; }
__device__ __forceinline__ int crow(int r, int hi) { return (r & 3) + 8 * (r >> 2) + 4 * hi; }
__device__ __forceinline__ unsigned cvtpk(float lo, float hi) {
    unsigned r; asm volatile("v_cvt_pk_bf16_f32 %0, %1, %2" : "=v"(r) : "v"(lo), "v"(hi)); return r;
}
__device__ __forceinline__ bf16x8 pack8(f32x4 a, f32x4 b) {
    u32x4 w = {cvtpk(a[0], a[1]), cvtpk(a[2], a[3]), cvtpk(b[0], b[1]), cvtpk(b[2], b[3])};
    return *reinterpret_cast<bf16x8*>(&w);
}
template <class T> __device__ __forceinline__ bf16x8 load8(const T* p) {
    if constexpr (same_t<T, float>::v) { return pack8(*(const f32x4*)p, *(const f32x4*)(p + 4)); }
    else { return *reinterpret_cast<const bf16x8*>(p); }
}
__device__ __forceinline__ void mask_tile(f32x16& p0, f32x16& p1, int dq, unsigned W) {
    const float NEG = -__builtin_inff();
#pragma unroll
    for (int r = 0; r < 16; ++r) {
        const int c = (r & 3) + 8 * (r >> 2);
        if ((unsigned)(dq - c) >= W) p0[r] = NEG;
        if ((unsigned)(dq - c - 32) >= W) p1[r] = NEG;
    }
}
__device__ __forceinline__ void partialSM(f32x16& p0, f32x16& p1, float& m_reg, float& mn, float& alpha) {
    float pmax = p0[0]; for (int r = 1; r < 16; ++r) pmax = fmaxf(pmax, p0[r]); for (int r = 0; r < 16; ++r) pmax = fmaxf(pmax, p1[r]);
    { auto rr = __builtin_amdgcn_permlane32_swap(__float_as_uint(pmax), __float_as_uint(pmax), false, false);
      pmax = fmaxf(__uint_as_float(rr[0]), __uint_as_float(rr[1])); }
    constexpr float C2 = 1.4426950408889634f * SCALE;
    if (__builtin_expect(__all((pmax - m_reg) * SCALE <= THR), 1)) { mn = m_reg; alpha = 1.f; }
    else { mn = fmaxf(m_reg, pmax); alpha = __builtin_amdgcn_exp2f((m_reg - mn) * C2); m_reg = mn; }
    const float mnL = -mn * C2;
    for (int r = 0; r < 16; ++r) p0[r] = fmaf(p0[r], C2, mnL); for (int r = 0; r < 16; ++r) p1[r] = fmaf(p1[r], C2, mnL);
    for (int r = 0; r < 16; ++r) p0[r] = __builtin_amdgcn_exp2f(p0[r]);
}
__device__ __forceinline__ void finishSM(f32x16& p0, f32x16& p1, float alpha, float& l_reg, bf16x8& pa0, bf16x8& pa1, bf16x8& pa2, bf16x8& pa3) {
    for (int r = 0; r < 16; ++r) p1[r] = __builtin_amdgcn_exp2f(p1[r]);
    float ps = 0; for (int r = 0; r < 16; ++r) ps += p0[r]; for (int r = 0; r < 16; ++r) ps += p1[r];
    { auto rr = __builtin_amdgcn_permlane32_swap(__float_as_uint(ps), __float_as_uint(ps), false, false);
      ps = __uint_as_float(rr[0]) + __uint_as_float(rr[1]); }
    l_reg = l_reg * alpha + ps;
#define PK4(P, B_, OUT) do { unsigned a0 = cvtpk(P[B_+0], P[B_+1]), a1 = cvtpk(P[B_+2], P[B_+3]);                          \
        unsigned b0 = cvtpk(P[B_+4], P[B_+5]), b1 = cvtpk(P[B_+6], P[B_+7]);                                             \
        auto r0 = __builtin_amdgcn_permlane32_swap(a0, b0, false, false); auto r1 = __builtin_amdgcn_permlane32_swap(a1, b1, false, false); \
        u32x4 w = {r0[0], r1[0], r0[1], r1[1]}; OUT = *reinterpret_cast<bf16x8*>(&w); } while (0)
    PK4(p0, 0, pa0); PK4(p0, 8, pa1); PK4(p1, 0, pa2); PK4(p1, 8, pa3);
#undef PK4
}
template <int KB, bool SK>
__device__ __forceinline__ void qkt(f32x16& p0, f32x16& p1, const char* K_lds, int r32, int hi, const char* Qw, bool act, float Aal, float ab) {
    if (SK && !act) { const float NEG = -__builtin_inff();
#pragma unroll
        for (int r = 0; r < 16; ++r) { p0[r] = NEG; p1[r] = NEG; } return; }
#pragma unroll
    for (int r = 0; r < 16; ++r) { const float c = (float)((r & 3) + 8 * (r >> 2)); p0[r] = fmaf(Aal, c, ab); p1[r] = fmaf(Aal, c + 32.f, ab); }
    const char* kb[4]; const char* qa[4];
#pragma unroll
    for (int dd = 0; dd < 4; ++dd) { kb[dd] = K_lds + KB * SHM_K + KSWZ(r32, (dd * 16 + hi * 8) * 2); qa[dd] = Qw + KSWZ(r32, (dd * 16 + hi * 8) * 2); }
#pragma unroll
    for (int d0 = 0; d0 < 8; ++d0) { const char* a = kb[d0 & 3] + (d0 >> 2) * 128;
        bf16x8 b0 = *reinterpret_cast<const bf16x8*>(a);
        bf16x8 b1 = *reinterpret_cast<const bf16x8*>(a + 32 * 256);
        bf16x8 qf = *reinterpret_cast<const bf16x8*>(qa[d0 & 3] + (d0 >> 2) * 128);
        p0 = __builtin_amdgcn_mfma_f32_32x32x16_bf16(b0, qf, p0, 0, 0, 0);
        p1 = __builtin_amdgcn_mfma_f32_32x32x16_bf16(b1, qf, p1, 0, 0, 0); }
}
template <int VB, bool SK>
__device__ __forceinline__ void pv_tile(f32x16* o, int vb0, bf16x8 pa0, bf16x8 pa1, bf16x8 pa2, bf16x8 pa3, bool act) {
    if (SK && !act) return;
#define TRRD(dst, off) asm volatile("ds_read_b64_tr_b16 %0, %1 offset:%2" : "=&v"(dst) : "v"(vb0), "i"(off) : "memory")
#define PV_D0(d0) do { s16x4 l0, l1, l2, l3, h0, h1, h2, h3; constexpr int b_ = VB * SHM_V + v_rd_off(d0, 0, 0);     \
        TRRD(l0, b_); TRRD(h0, b_ + 2048); TRRD(l1, b_ + 4096); TRRD(h1, b_ + 6144); TRRD(l2, b_ + 8192); TRRD(h2, b_ + 10240); TRRD(l3, b_ + 12288); TRRD(h3, b_ + 14336); \
        asm volatile("s_waitcnt lgkmcnt(0)" ::: "memory"); SBAR();                 \
        o[d0] = __builtin_amdgcn_mfma_f32_32x32x16_bf16(pa0, (bf16x8){l0[0], l0[1], l0[2], l0[3], h0[0], h0[1], h0[2], h0[3]}, o[d0], 0, 0, 0);   \
        o[d0] = __builtin_amdgcn_mfma_f32_32x32x16_bf16(pa1, (bf16x8){l1[0], l1[1], l1[2], l1[3], h1[0], h1[1], h1[2], h1[3]}, o[d0], 0, 0, 0);   \
        o[d0] = __builtin_amdgcn_mfma_f32_32x32x16_bf16(pa2, (bf16x8){l2[0], l2[1], l2[2], l2[3], h2[0], h2[1], h2[2], h2[3]}, o[d0], 0, 0, 0);   \
        o[d0] = __builtin_amdgcn_mfma_f32_32x32x16_bf16(pa3, (bf16x8){l3[0], l3[1], l3[2], l3[3], h3[0], h3[1], h3[2], h3[3]}, o[d0], 0, 0, 0); } while (0)
    PV_D0(0); PV_D0(1); PV_D0(2); PV_D0(3);
#undef PV_D0
#undef TRRD
}

template <class TIn, class TOut> struct BlockRef { const TIn* Q; const TIn* K; const TIn* V; TOut* O; int P0; const float* km; float Aal; };
template <class TIn> struct Seam {
    bf16x8 qr[8];
    bf16x8 st_v0, st_v1, st_k0, st_k1; f32x4 sf0, sf1, sf2, sf3;
    f32x4 tq[16];
};
__device__ __forceinline__ int swa_jlo(int P0, int W) { const int lowk = P0 - W + 1; return lowk > 0 ? lowk / KVBLK : 0; }
#define ROW(p, k0, rr) ((p) + (size_t)((k0) + (rr)) * D + sc)
#define VMW() asm volatile("s_waitcnt vmcnt(0)" ::: "memory")
#define VMWN(n) asm volatile("s_waitcnt vmcnt(%0)" :: "i"(n) : "memory")
#define SLOAD_H(Kp, Vp, k0) do { S.st_v0 = load8<TIn>(ROW(Vp, k0, sr)); S.st_v1 = load8<TIn>(ROW(Vp, k0, 32 + sr));              \
                         S.st_k0 = load8<TIn>(ROW(Kp, k0, sr)); S.st_k1 = load8<TIn>(ROW(Kp, k0, 32 + sr)); } while (0)
#define SWRITE_HK(bf) do { *(bf16x8*)(K_lds + (bf) * SHM_K + kws) = S.st_k0; *(bf16x8*)(K_lds + (bf) * SHM_K + kws + 32 * 256) = S.st_k1; } while (0)
#define SWRITE_HV(bf) do { *(bf16x8*)(V_lds + (bf) * SHM_V + vst0) = S.st_v0; *(bf16x8*)(V_lds + (bf) * SHM_V + vst1) = S.st_v1; } while (0)
#define SWRITE_H(bf) do { SWRITE_HV(bf); SWRITE_HK(bf); } while (0)
#define SLOAD_F(p, k0) do { S.sf0 = *(const f32x4*)ROW(p, k0, sr); S.sf1 = *(const f32x4*)(ROW(p, k0, sr) + 4);                \
                            S.sf2 = *(const f32x4*)ROW(p, k0, 32 + sr); S.sf3 = *(const f32x4*)(ROW(p, k0, 32 + sr) + 4); } while (0)
#define SWRITE_KF(bf) do { *(bf16x8*)(K_lds + (bf) * SHM_K + kws) = pack8(S.sf0, S.sf1); *(bf16x8*)(K_lds + (bf) * SHM_K + kws + 32 * 256) = pack8(S.sf2, S.sf3); } while (0)
#define SWRITE_VF(bf) do { *(bf16x8*)(V_lds + (bf) * SHM_V + vst0) = pack8(S.sf0, S.sf1); *(bf16x8*)(V_lds + (bf) * SHM_V + vst1) = pack8(S.sf2, S.sf3); } while (0)
template <class TIn, class TOut>
__device__ __forceinline__ void causal_swa_prime(const BlockRef<TIn, TOut>& cur, int W, char* lds, Seam<TIn>& S) {
    constexpr bool F32 = same_t<TIn, float>::v;
    const int tid = threadIdx.x, wid = __builtin_amdgcn_readfirstlane(tid >> 6), lane = tid & 63, r32 = lane & 31, hi = lane >> 5;
    const int sr = tid >> 4, sc = (tid & 15) * 8, kws = KSWZ(sr, sc * 2); char* K_lds = lds + 2 * SHM_V;
    const int kb0 = swa_jlo(cur.P0, W) * KVBLK;
    for (int d0 = 0; d0 < 8; ++d0) S.qr[d0] = load8<TIn>(cur.Q + (size_t)(wid * QBLK + r32) * D + d0 * 16 + hi * 8);
    if constexpr (F32) { SLOAD_F((const float*)cur.K, kb0); VMW(); SWRITE_KF(0); SBAR(); SLOAD_F((const float*)cur.V, kb0); }
    else { SLOAD_H(cur.K, cur.V, kb0); VMW(); SWRITE_HK(0); }
    { char* Qw = lds + LDS_BYTES + wid * 8192;
#pragma unroll
      for (int d0 = 0; d0 < 8; ++d0) *(bf16x8*)(Qw + KSWZ(r32, (d0 * 16 + hi * 8) * 2)) = S.qr[d0]; }
    __syncthreads();
}
template <class TIn, class TOut>
__device__ __forceinline__ void causal_swa_block(const BlockRef<TIn, TOut>& cur, const BlockRef<TIn, TOut>& nxt, int skv, int W, char* lds, Seam<TIn>& S) {
    constexpr bool F32 = same_t<TIn, float>::v;
    const int tid = threadIdx.x, wid = __builtin_amdgcn_readfirstlane(tid >> 6), lane = tid & 63, r32 = lane & 31, hi = lane >> 5;
    const int j_lo = swa_jlo(cur.P0, W);
    int j_hi = (cur.P0 + QB - 1) / KVBLK + 1; if (j_hi > skv / KVBLK) j_hi = skv / KVBLK;
    const int NT = j_hi - j_lo;
    const int kbn = swa_jlo(nxt.P0, W) * KVBLK;
    const int qb = cur.P0 >> 8; const float Aal = cur.Aal; const int aref = cur.P0 + QB - 1 - 4 * hi;
    const int qlo = cur.P0 + wid * QBLK, qm = qlo + r32 - 4 * hi;
    char* V_lds = lds; char* K_lds = lds + 2 * SHM_V; char* Qw = lds + LDS_BYTES + wid * 8192;
    float* ws = (float*)(lds + 2 * SHM_V + 2 * SHM_K) + wid * 64; float* li_l = ws, * al_l = ws + 32;
    float m_reg = -1e30f, l_reg = 0; f32x16 o[4] = {};
    const int sr = tid >> 4, sc = (tid & 15) * 8, vst0 = v_st(sr, sc), vst1 = v_st(32 + sr, sc), kws = KSWZ(sr, sc * 2);
    const int vb0 = (int)(uintptr_t)V_lds + v_rd_base(lane);
    const TIn* Kh = cur.K; const TIn* Vh = cur.V;
#define RESC(a) do { if (__any((a) < 1.f)) { if (hi == 0) al_l[r32] = (a); asm volatile("s_waitcnt lgkmcnt(0)" ::: "memory");              \
                     for (int d_ = 0; d_ < 4; ++d_) for (int r = 0; r < 16; ++r) o[d_][r] *= al_l[crow(r, hi)]; } } while (0)
#define KBASE(t) ((j_lo + (t)) * KVBLK)
#define ACT(t) (KBASE(t) <= qlo + QBLK - 1 && KBASE(t) + KVBLK - 1 >= qlo - W + 1)
#define AB(t) (Aal * (float)(KBASE(t) - aref))
#define MASKT(P0_, P1_, t) do { const int kb_ = KBASE(t); const int jb_ = kb_ >> 8;                                         \
        if (jb_ == qb) { if (kb_ + KVBLK - 1 > qlo) mask_tile(P0_, P1_, qm - kb_, 0x7fffffffu); }                          \
        else if (qb > 3) { const bool on_ = ((sel >> jb_) & 1) != 0; if (!__all(on_)) { const float NEG_ = -__builtin_inff();   \
            _Pragma("unroll") for (int r_ = 0; r_ < 16; ++r_) { P0_[r_] = on_ ? P0_[r_] : NEG_; P1_[r_] = on_ ? P1_[r_] : NEG_; } } } } while (0)
    constexpr int NQL = F32 ? 16 : 8;
    constexpr bool SK = false;
#define SEAM_K0() do { VMWN(NQL); if constexpr (F32) { SWRITE_KF(0); SBAR(); SLOAD_F((const float*)nxt.V, kbn); } else { SWRITE_HK(0); } SBAR(); } while (0)
    f32x16 pA0, pA1, pB0, pB1; float mnA, mnB, alA, alB; bf16x8 pa0, pa1, pa2, pa3;
    int sel = (1 << qb) - 1;
    if (qb > 3) {
        float v1 = -__builtin_inff(), v2 = v1, v3 = v1; int m1 = 0, m2 = 0, m3 = 0;
#pragma nounroll
        for (int j = 0; j < qb; ++j) { const float* k0 = cur.km + (size_t)(2 * j) * 2048 + hi * 8; float acc = 0.f;
#pragma unroll
            for (int d0 = 0; d0 < 8; ++d0) { const f32x4 a0 = *(const f32x4*)(k0 + d0 * 16) + *(const f32x4*)(k0 + 2048 + d0 * 16), a1 = *(const f32x4*)(k0 + d0 * 16 + 4) + *(const f32x4*)(k0 + 2048 + d0 * 16 + 4);
                const bf16x8 q = S.qr[d0];
#pragma unroll
                for (int e = 0; e < 4; ++e) { acc = fmaf(__builtin_bit_cast(float, (unsigned)(unsigned short)q[e] << 16), a0[e], acc); acc = fmaf(__builtin_bit_cast(float, (unsigned)(unsigned short)q[e + 4] << 16), a1[e], acc); } }
            { auto rr = __builtin_amdgcn_permlane32_swap(__float_as_uint(acc), __float_as_uint(acc), false, false); acc = __uint_as_float(rr[0]) + __uint_as_float(rr[1]); }
            const int mj = 1 << j; const bool g1 = acc > v1, g2 = acc > v2, g3 = acc > v3;
            v3 = g2 ? v2 : (g3 ? acc : v3); m3 = g2 ? m2 : (g3 ? mj : m3);
            v2 = g1 ? v1 : (g2 ? acc : v2); m2 = g1 ? m1 : (g2 ? mj : m2);
            v1 = g1 ? acc : v1; m1 = g1 ? mj : m1; }
        sel = m1 | m2 | m3;
    }
    if constexpr (F32) { VMW(); SWRITE_VF(0); SBAR(); } else { SWRITE_HV(0); SBAR(); }
    if (NT > 1) { if constexpr (F32) SLOAD_F((const float*)Kh, KBASE(1)); else SLOAD_H(Kh, Vh, KBASE(1)); }
    SBAR(); qkt<0, SK>(pA0, pA1, K_lds, r32, hi, Qw, ACT(0), Aal, AB(0));
    if constexpr (F32) { if (NT > 1) { VMW(); SWRITE_KF(1); SBAR(); SLOAD_F((const float*)Vh, KBASE(1)); } }
    MASKT(pA0, pA1, 0); partialSM(pA0, pA1, m_reg, mnA, alA);
    if (NT > 1) { VMW(); if constexpr (F32) { SWRITE_VF(1); SBAR(); if (NT > 2) SLOAD_F((const float*)Kh, KBASE(2)); } else SWRITE_H(1); }
    __syncthreads();
#define HALF_STEP(PX0, PX1, mnX, alX, PY0, PY1, alY, t, KB, VB, SB) do {                                                      \
        SBAR(); qkt<KB, SK>(PX0, PX1, K_lds, r32, hi, Qw, ACT(t), Aal, AB(t));                                             \
        finishSM(PY0, PY1, alY, l_reg, pa0, pa1, pa2, pa3); SBAR();                                                           \
        if ((t) + 1 < NT) { if constexpr (F32) { VMW(); SWRITE_KF(SB); SBAR(); SLOAD_F((const float*)Vh, KBASE((t) + 1)); }  \
                            else { SLOAD_H(Kh, Vh, KBASE((t) + 1)); } SBAR(); }                                               \
        pv_tile<VB, SK>(o, vb0, pa0, pa1, pa2, pa3, ACT((t) - 1)); MASKT(PX0, PX1, (t)); partialSM(PX0, PX1, m_reg, mnX, alX);                                        \
        __syncthreads();                                                                                                      \
        if ((t) + 1 < NT) { VMW(); if constexpr (F32) { SWRITE_VF(SB); SBAR(); if ((t) + 2 < NT) SLOAD_F((const float*)Kh, KBASE((t) + 2)); } \
                            else { SWRITE_H(SB); } }                                                                          \
        RESC(alX); __syncthreads(); } while (0)
    for (int t = 1; t + 1 < NT; t += 2) {
        HALF_STEP(pB0, pB1, mnB, alB, pA0, pA1, alA, t, 1, 0, 0);
        HALF_STEP(pA0, pA1, mnA, alA, pB0, pB1, alB, t + 1, 0, 1, 1);
    }
    const bool even = (NT & 1) == 0;
    if (even) { SBAR(); qkt<1, SK>(pB0, pB1, K_lds, r32, hi, Qw, ACT(NT - 1), Aal, AB(NT - 1)); SBAR(); }
#define QROW(e) (nxt.Q + (size_t)(wid * QBLK + r32) * D + ((e) >> 1) * 16 + hi * 8 + ((e) & 1) * 4)
    if constexpr (F32) { SLOAD_F((const float*)nxt.K, kbn); SBAR();
#pragma unroll
        for (int e = 0; e < 8; ++e) S.tq[e] = *(const f32x4*)QROW(e); }
    else { SLOAD_H(nxt.K, nxt.V, kbn); SBAR();
#pragma unroll
        for (int d0 = 0; d0 < 8; ++d0) S.qr[d0] = load8<TIn>(nxt.Q + (size_t)(wid * QBLK + r32) * D + d0 * 16 + hi * 8); }
    SBAR();
    finishSM(pA0, pA1, alA, l_reg, pa0, pa1, pa2, pa3); SBAR();
    if constexpr (F32) {
#pragma unroll
        for (int e = 8; e < 16; ++e) S.tq[e] = *(const f32x4*)QROW(e); SBAR(); }
#undef QROW
    pv_tile<0, SK>(o, vb0, pa0, pa1, pa2, pa3, ACT(even ? NT - 2 : NT - 1));
    if (even) { MASKT(pB0, pB1, NT - 1); partialSM(pB0, pB1, m_reg, mnB, alB); __syncthreads(); RESC(alB);
        finishSM(pB0, pB1, alB, l_reg, pa0, pa1, pa2, pa3); SBAR(); pv_tile<1, SK>(o, vb0, pa0, pa1, pa2, pa3, ACT(NT - 1)); }
    SBAR(); SEAM_K0();
    if (hi == 0) li_l[r32] = l_reg; asm volatile("s_waitcnt lgkmcnt(0)" ::: "memory");
    float rli[16];
#pragma unroll
    for (int r = 0; r < 16; ++r) rli[r] = __builtin_amdgcn_rcpf(li_l[crow(r, hi)]);
    TOut* Ow = cur.O + (size_t)(wid * QBLK) * OSTR;
#pragma unroll
    for (int r = 0; r < 16; ++r) { const int orow = crow(r, hi);
#pragma unroll
        for (int d0 = 0; d0 < 4; ++d0) { const float v = o[d0][r] * rli[r];
            if constexpr (same_t<TOut, float>::v) { Ow[(size_t)orow * OSTR + d0 * 32 + r32] = v; }
            else { const float vn = __shfl_xor(v, 1);
                   if ((r32 & 1) == 0) *(unsigned*)(Ow + (size_t)orow * OSTR + d0 * 32 + r32) = cvtpk(v, vn); } } }
    if constexpr (F32) {
#pragma unroll
        for (int d0 = 0; d0 < 8; ++d0) S.qr[d0] = pack8(S.tq[2 * d0], S.tq[2 * d0 + 1]); }
    VMW();
#pragma unroll
    for (int d0 = 0; d0 < 8; ++d0) *(bf16x8*)(Qw + KSWZ(r32, (d0 * 16 + hi * 8) * 2)) = S.qr[d0];
    __syncthreads();
#undef RESC
#undef KBASE
#undef ACT
#undef MASKT
#undef AB
#undef SEAM_K0
#undef HALF_STEP
}
#undef ROW
#undef VMW
#undef VMWN
#undef SLOAD_H
#undef SWRITE_HK
#undef SWRITE_HV
#undef SWRITE_H
#undef SLOAD_F
#undef SWRITE_KF
#undef SWRITE_VF

}

struct Frame {
    LAS unsigned char* lds;
    volatile LAS unsigned* MISC;
    gu32* ctl;
    int vcu, G;
};
__device__ __forceinline__ float wave_sum(float v) {
#pragma unroll
    for (int o = 1; o < 64; o <<= 1) v += __shfl_xor(v, o);
    return v;
}
__device__ __forceinline__ void p0_item64(const float* src, int Nsrc, int sc, const float* g, bf16* WT, int K, int nrow0, int k0, LAS float* scr, int lane) {
    const int lr = lane >> 4, lu = lane & 15;
    f32x4 v[16];
#pragma unroll
    for (int i = 0; i < 16; ++i) v[i] = *(const GAS f32x4*)(src + (size_t)(k0 + 4 * i + lr) * Nsrc + sc + 4 * lu);
    if (g) {
#pragma unroll
        for (int i = 0; i < 16; ++i) v[i] = v[i] * g[k0 + 4 * i + lr]; }
#pragma unroll
    for (int i = 0; i < 16; ++i) { const int k = 4 * i + lr; *(LAS f32x4*)(scr + k * 64 + ((lu ^ ((k >> 3) & 7)) << 2)) = v[i]; }
    LDS_WAIT(); asm volatile("" ::: "memory");
    const int c = lane & 7;
#pragma unroll
    for (int j = 0; j < 8; ++j) { const int n = (lane >> 3) + 8 * j; const LAS float* s = scr + (8 * c) * 64 + (((n >> 2) ^ c) << 2) + (n & 3);
        v4u o; o.x = pk2(s[0 * 64], s[1 * 64]); o.y = pk2(s[2 * 64], s[3 * 64]); o.z = pk2(s[4 * 64], s[5 * 64]); o.w = pk2(s[6 * 64], s[7 * 64]);
        *(GAS v4u*)(WT + (size_t)(nrow0 + n) * K + k0 + 8 * c) = o; }
    LDS_WAIT(); asm volatile("" ::: "memory");
}
struct Args { const float* in[17]; float* out; unsigned char* ws; int ph_mask, li; };

__device__ __forceinline__ void p0_prologue(Frame& F, const Args& a) {
    LAS float* scr = (LAS float*)(F.lds + RING_OFF + __builtin_amdgcn_readfirstlane((int)threadIdx.x >> 6) * 16384);
    const int gw = F.vcu * NWAVES + __builtin_amdgcn_readfirstlane((int)threadIdx.x >> 6), NGW = F.G * NWAVES;
    unsigned char* ws = a.ws;
    constexpr int I_DUAL = (D / 64) * (2 * FF / 64), I_DOWN = (FF / 64) * (D / 64), I_IN = (D / 64) * (INW / 64), I_SQ = (D / 64) * (D / 64);
    constexpr int NITEMS = 2 * I_DUAL + 2 * I_DOWN + I_IN + 3 * I_SQ;
    for (int it = gw; it < NITEMS; it += NGW) {
        int r = it;
        if (r < I_DUAL) {
            const int nblk = 2 * FF / 64, kb = r / nblk, nb = r % nblk, n0 = 64 * nb, j = n0 >> 8, c = n0 & 255;
            p0_item64(c < 128 ? a.in[2] : a.in[3], FF, 128 * j + (c & 127), a.in[1], (bf16*)(ws + WS_W1), D, n0, 64 * kb, scr, ((int)threadIdx.x & 63)); continue; } r -= I_DUAL;
        if (r < I_DOWN) { const int nblk = D / 64, kb = r / nblk, nb = r % nblk;
            p0_item64(a.in[4], D, 64 * nb, nullptr, (bf16*)(ws + WS_W2), FF, 64 * nb, 64 * kb, scr, ((int)threadIdx.x & 63)); continue; } r -= I_DOWN;
        if (r < I_IN) { const int nblk = INW / 64, kb = r / nblk, nb = r % nblk, n0 = 64 * nb; int sc = n0;
            if (n0 >= 8192 && n0 < 12288) { const int t = n0 - 8192, j = t >> 8, c = t & 255; sc = c < 128 ? 8192 + 128 * j + c : 10240 + 128 * j + (c - 128); }
            p0_item64(a.in[6], INW, sc, a.in[5], (bf16*)(ws + WS_WIN), D, n0, 64 * kb, scr, ((int)threadIdx.x & 63)); continue; } r -= I_IN;
        if (r < 3 * I_SQ) { const int w = r / I_SQ, q = r % I_SQ, nblk = D / 64, kb = q / nblk, nb = q % nblk;
            p0_item64(a.in[9 + w], D, 64 * nb, nullptr, (bf16*)(ws + WS_WA + (size_t)w * 8 * MiB), D, 64 * nb, 64 * kb, scr, ((int)threadIdx.x & 63)); continue; } r -= 3 * I_SQ;
        if (r < I_DUAL) { const int nblk = 2 * FF / 64, kb = r / nblk, nb = r % nblk, n0 = 64 * nb, j = n0 >> 8, c = n0 & 255;
            p0_item64(c < 128 ? a.in[13] : a.in[14], FF, 128 * j + (c & 127), a.in[12], (bf16*)(ws + WS_W3), D, n0, 64 * kb, scr, ((int)threadIdx.x & 63)); continue; } r -= I_DUAL;
        { const int nblk = D / 64, kb = r / nblk, nb = r % nblk;
            p0_item64(a.in[15], D, 64 * nb, nullptr, (bf16*)(ws + WS_W4), FF, 64 * nb, 64 * kb, scr, ((int)threadIdx.x & 63)); }
    }
    const float* x = a.in[0]; bf16* XB = (bf16*)(ws + WS_XB); float* ss1 = (float*)(ws + WS_CTL) + CW_SS1;
    for (int m = gw; m < M; m += NGW) {
        const GAS f32x4* xr = (const GAS f32x4*)(x + (size_t)m * D) + ((int)threadIdx.x & 63); GAS unsigned long long* o8 = (GAS unsigned long long*)(XB + (size_t)m * D) + ((int)threadIdx.x & 63); float s = 0.f;
#pragma unroll
        for (int j = 0; j < 8; ++j) { const f32x4 v = xr[64 * j]; s += (v.x * v.x + v.y * v.y) + (v.z * v.z + v.w * v.w);
            o8[64 * j] = (unsigned long long)pk2(v.x, v.y) | ((unsigned long long)pk2(v.z, v.w) << 32); }
        s = wave_sum(s); if (((int)threadIdx.x & 63) == 0) ss1[m] = s;
    }
}

__device__ __forceinline__ void p4_conv(Frame& F, const Args& a) {
    const int ch = (((int)threadIdx.x) & 255) * 8, row0 = 32 * F.vcu + 16 * (((int)threadIdx.x) >> 8);
    const bf16* U = (const bf16*)(a.ws + WS_U); bf16* GBp = (bf16*)(a.ws + WS_GB); const float* cw = a.in[8];
    float w0[8], w1[8], w2[8];
#pragma unroll
    for (int e = 0; e < 8; ++e) { w0[e] = cw[ch + e]; w1[e] = cw[D + ch + e]; w2[e] = cw[2 * D + ch + e]; }
    float um1[8], um2[8];
    const bool first = (row0 & (S - 1)) == 0;
    { v4u a1 = (v4u){0u, 0u, 0u, 0u}, a2 = a1;
      if (!first) { a1 = *(const GAS v4u*)(U + (size_t)(row0 - 1) * D + ch); a2 = *(const GAS v4u*)(U + (size_t)(row0 - 2) * D + ch); }
#pragma unroll
      for (int e = 0; e < 4; ++e) { um1[2 * e] = __builtin_bit_cast(float, a1[e] << 16); um1[2 * e + 1] = __builtin_bit_cast(float, a1[e] & 0xffff0000u);
                                    um2[2 * e] = __builtin_bit_cast(float, a2[e] << 16); um2[2 * e + 1] = __builtin_bit_cast(float, a2[e] & 0xffff0000u); } }
#pragma unroll 4
    for (int i = 0; i < 16; ++i) { const size_t off = (size_t)(row0 + i) * D + ch;
        const v4u uu = *(const GAS v4u*)(U + off), gg = *(const GAS v4u*)(GBp + off); float u[8], g[8], c[8];
#pragma unroll
        for (int e = 0; e < 4; ++e) { u[2 * e] = __builtin_bit_cast(float, uu[e] << 16); u[2 * e + 1] = __builtin_bit_cast(float, uu[e] & 0xffff0000u);
                                      g[2 * e] = __builtin_bit_cast(float, gg[e] << 16); g[2 * e + 1] = __builtin_bit_cast(float, gg[e] & 0xffff0000u); }
#pragma unroll
        for (int e = 0; e < 8; ++e) { c[e] = g[e] * (w0[e] * um2[e] + w1[e] * um1[e] + w2[e] * u[e]); um2[e] = um1[e]; um1[e] = u[e]; }
        v4u o; o.x = pk2(c[0], c[1]); o.y = pk2(c[2], c[3]); o.z = pk2(c[4], c[5]); o.w = pk2(c[6], c[7]);
        *(GAS v4u*)(GBp + off) = o; }
}
__device__ __forceinline__ void p4_attention(Frame& F, const Args& a, char* lds) {
    typedef attn::bf16 ab16; typedef attn::BlockRef<ab16, ab16> Ref;
    const int bh = F.vcu >> 2, p = F.vcu & 3, b = bh >> 4, h = bh & 15;
    const ab16* Q = (const ab16*)(a.ws + WS_Q) + (size_t)bh * S * HD; const ab16* K = (const ab16*)(a.ws + WS_K) + (size_t)bh * S * HD; const ab16* V = (const ab16*)(a.ws + WS_V) + (size_t)bh * S * HD;
    ab16* O = (ab16*)(a.ws + WS_O) + (size_t)b * S * D + h * HD;
    const float* km = (const float*)(a.ws + WS_CTL) + CW_KPART + (size_t)(b * 8 * 2) * D + h * HD;
    const float Aal = __builtin_amdgcn_exp2f(-0.5f * (float)(h + 1)) * 11.313708498984761f;
    Ref r0, r1;
    r0.Q = Q + (size_t)(p * 256) * HD; r0.K = K; r0.V = V; r0.O = O + (size_t)(p * 256) * D; r0.P0 = p * 256; r0.km = km; r0.Aal = Aal;
    r1.Q = Q + (size_t)((7 - p) * 256) * HD; r1.K = K; r1.V = V; r1.O = O + (size_t)((7 - p) * 256) * D; r1.P0 = (7 - p) * 256; r1.km = km; r1.Aal = Aal;
    attn::Seam<ab16> Sm;
    attn::causal_swa_prime<ab16, ab16>(r0, 0x7fffffff, lds, Sm);
    Ref cur = r0;
#pragma nounroll
    for (int i = 0; i < 2; ++i) { attn::causal_swa_block<ab16, ab16>(cur, r1, S, 0x7fffffff, lds, Sm); cur = r1; }
}
__device__ __forceinline__ void p9_final(Frame& F, const Args& a) {
    const int gw = F.vcu * NWAVES + __builtin_amdgcn_readfirstlane((int)threadIdx.x >> 6), NGW = F.G * NWAVES;
    const float* ss4 = (const float*)(a.ws + WS_CTL) + CW_SS4; const float* gf = a.in[16];
    for (int m = gw; m < M; m += NGW) { const float r = __builtin_amdgcn_rsqf(ss4[m] * (1.0f / D) + EPS);
        GAS f32x4* xr = (GAS f32x4*)(a.out + (size_t)m * D) + ((int)threadIdx.x & 63); const GAS f32x4* gr = (const GAS f32x4*)gf + ((int)threadIdx.x & 63);
#pragma unroll
        for (int j = 0; j < 8; ++j) { f32x4 v = xr[64 * j]; const f32x4 g = gr[64 * j]; xr[64 * j] = v * r * g; } }
}

__global__ void __launch_bounds__(NWAVES * 64, 2) mk_fwd(Args args) {
    extern __shared__ __attribute__((aligned(16))) unsigned char lds[];
    Frame F;
    F.lds = (LAS unsigned char*)lds;
    F.MISC = (volatile LAS unsigned*)(F.lds + MISC_OFF);
    F.G = gridDim.x; { const int bx = blockIdx.x; F.vcu = (F.G % 8 == 0) ? (bx % 8) * (F.G / 8) + bx / 8 : bx; }
    unsigned char* ws = args.ws;
    F.ctl = (gu32*)(ws + WS_CTL);
    for (int u = ((int)threadIdx.x); u < (LDS_BYTES - LDSCTL_OFF) / 4; u += NWAVES * 64) ((LAS unsigned*)(F.lds + LDSCTL_OFF))[u] = 0u;
    __syncthreads();
    XcdBarrier bar = xcd_barrier_post((unsigned*)(F.ctl + CW_BAR) + args.li * XCD_BAR_WORDS, F.MISC + 8);
#define GRID_BAR() xcd_barrier(bar)
    const int phm = args.ph_mask;
#ifndef PH_MASK
#define PH_MASK 0x3ff
#endif
#define IN(k) (((PH_MASK >> (k)) & 1) && ((phm >> (k)) & 1))
#define BOTH(k) (IN(k) && ((phm & 0x3ff) >> ((k) + 1)) != 0)
    typedef pg8::bf16_t b16;
    float* ctlf = (float*)(ws + WS_CTL);
    b16* XB = (b16*)(ws + WS_XB); b16* H = (b16*)(ws + WS_H);
    const int G = F.G, bx = (int)blockIdx.x;
    constexpr int NOSPLIT = 1 << 30;

    if (IN(0)) { p0_prologue(F, args); if (BOTH(0)) GRID_BAR(); }
    if (IN(1)) {
        pg8::Gemm g{XB, (const b16*)(ws + WS_W1), M, 2 * FF, D, nullptr, NOSPLIT}; pg8::StaticOrder S; S.init(M, 2 * FF, G, bx);
        pg8::EpiSwiglu E{H, ctlf + CW_SS1};
        pg8::gemm_phase<pg8::EpiSwiglu, pg8::StaticOrder, true, true>(F.lds + RING_OFF, g, S, E);
        if (BOTH(1)) GRID_BAR();
    }
    if (IN(2)) {
        pg8::Gemm g{H, (const b16*)(ws + WS_W2), M, D, FF, nullptr, NOSPLIT}; pg8::StaticOrder S; S.init(M, D, G, bx);
        pg8::EpiResid E{args.in[0], args.out, XB, ctlf + CW_SS2, 0.5f, 0};
        pg8::gemm_phase<pg8::EpiResid, pg8::StaticOrder, true, true>(F.lds + RING_OFF, g, S, E);
        if (BOTH(2)) GRID_BAR();
    }
    if (IN(3)) {
        pg8::Gemm g{XB, (const b16*)(ws + WS_WIN), M, INW, D, nullptr, NOSPLIT}; pg8::StaticOrder S; S.init(M, INW, G, bx);
        pg8::EpiIn E{(b16*)(ws + WS_Q), (b16*)(ws + WS_GB), (b16*)(ws + WS_U), (b16*)(ws + WS_GA), ctlf + CW_SS2, args.in[7], ctlf + CW_KPART};
        pg8::gemm_phase<pg8::EpiIn, pg8::StaticOrder, true, true>(F.lds + RING_OFF, g, S, E);
        if (BOTH(3)) GRID_BAR();
    }
    if (IN(4)) {
        if (F.G == 256) { if ((phm >> 10) & 1) p4_conv(F, args); p4_attention(F, args, (char*)lds); }
        if (BOTH(4)) GRID_BAR();
    }
    if (IN(5)) {
        pg8::Gemm g{(const b16*)(ws + WS_O), (const b16*)(ws + WS_WA), M, 2 * D, D, (const b16*)(ws + WS_GB), 8}; pg8::PairOrder S; S.so.init(M, D, G, bx);
        pg8::EpiMix E{(float*)(ws + WS_T), (const b16*)(ws + WS_GA), (const b16*)(ws + WS_GC), (b16*)(ws + WS_M)};
        pg8::gemm_phase<pg8::EpiMix, pg8::PairOrder, true, true>(F.lds + RING_OFF, g, S, E);
        if (BOTH(5)) GRID_BAR();
    }
    if (IN(6)) {
        pg8::Gemm g{(const b16*)(ws + WS_M), (const b16*)(ws + WS_WO), M, D, D, nullptr, NOSPLIT}; pg8::StaticOrder S; S.init(M, D, G, bx);
        pg8::EpiResid E{args.out, args.out, XB, ctlf + CW_SS3, 1.0f, 0};
        pg8::gemm_phase<pg8::EpiResid, pg8::StaticOrder, true, true>(F.lds + RING_OFF, g, S, E);
        if (BOTH(6)) GRID_BAR();
    }
    if (IN(7)) {
        pg8::Gemm g{XB, (const b16*)(ws + WS_W3), M, 2 * FF, D, nullptr, NOSPLIT}; pg8::StaticOrder S; S.init(M, 2 * FF, G, bx);
        pg8::EpiSwiglu E{H, ctlf + CW_SS3};
        pg8::gemm_phase<pg8::EpiSwiglu, pg8::StaticOrder, true, true>(F.lds + RING_OFF, g, S, E);
        if (BOTH(7)) GRID_BAR();
    }
    if (IN(8)) {
        pg8::Gemm g{H, (const b16*)(ws + WS_W4), M, D, FF, nullptr, NOSPLIT}; pg8::StaticOrder S; S.init(M, D, G, bx);
        pg8::EpiResid E{args.out, args.out, nullptr, ctlf + CW_SS4, 0.5f, 0};
        pg8::gemm_phase<pg8::EpiResid, pg8::StaticOrder, true, true>(F.lds + RING_OFF, g, S, E);
        if (BOTH(8)) GRID_BAR();
    }
    if (IN(9)) p9_final(F, args);
#undef IN
#undef BOTH
}

typedef unsigned short bf16_t;
__device__ __forceinline__ unsigned f2bf_s(float f) { unsigned u = __builtin_bit_cast(unsigned, f); return (u + 0x7fffu + ((u >> 16) & 1u)) >> 16; }
__device__ __forceinline__ float bf2f(bf16_t b) { return __builtin_bit_cast(float, (unsigned)b << 16); }
__global__ __launch_bounds__(256) void km_from_parts(const float* __restrict__ kpart, float* __restrict__ km) {
    const int i = blockIdx.x * 256 + threadIdx.x, pm = i >> 11, c = i & 2047;
    km[i] = (kpart[(size_t)(pm * 2) * D + c] + kpart[(size_t)(pm * 2 + 1) * D + c]) * (1.f / 256.f);
}
__global__ __launch_bounds__(256) void attn_simple(const bf16_t* __restrict__ Q, const bf16_t* __restrict__ Kb, const bf16_t* __restrict__ Vb, const float* __restrict__ km, bf16_t* __restrict__ O) {
    __shared__ float q_s[128], gate_s[8], p_s[1024], red_s[8], acc_s[128];
    __shared__ int blk_s[4], cnt_s;
    const int tid = threadIdx.x, lane = tid & 63, w = tid >> 6;
    const int bh = blockIdx.x >> 11, s = blockIdx.x & 2047, b = bh >> 4, h = bh & 15, own = s >> 8;
    const float slope = exp2f(-0.5f * (float)(h + 1)), scale = 0.08838834764831845f;
    if (tid < 128) q_s[tid] = bf2f(Q[((size_t)bh * S + s) * HD + tid]);
    __syncthreads();
    for (int j = w; j < own; j += 4) { const float* kmp = km + (size_t)(b * 8 + j) * D + h * HD; float p = q_s[lane] * kmp[lane] + q_s[lane + 64] * kmp[lane + 64];
        for (int o = 1; o < 64; o <<= 1) p += __shfl_xor(p, o);
        if (lane == 0) gate_s[j] = p; }
    __syncthreads();
    if (tid == 0) { unsigned mask = 0; if (own <= 3) mask = (1u << own) - 1u; else { for (int it = 0; it < 3; ++it) { int best = -1; float bv = 0.f; for (int j = 0; j < own; ++j) if (!((mask >> j) & 1u) && (best < 0 || gate_s[j] > bv)) { best = j; bv = gate_s[j]; } mask |= 1u << best; } }
        int c = 0; for (int j = 0; j < own; ++j) if ((mask >> j) & 1u) blk_s[c++] = j; blk_s[c++] = own; cnt_s = c; }
    __syncthreads();
    const int cnt = cnt_s; float mx = -INFINITY;
    for (int c = 0; c < cnt; ++c) { const int j = blk_s[c], pos = j * 256 + tid; const bf16_t* kp = Kb + ((size_t)bh * S + pos) * HD; float dot = 0.f;
        for (int d8 = 0; d8 < 16; ++d8) { const bf16x8 kv = *(const bf16x8*)(kp + d8 * 8); for (int e = 0; e < 8; ++e) dot += q_s[d8 * 8 + e] * bf2f((bf16_t)kv[e]); }
        float sc = dot * scale - slope * (float)(s - pos); if (pos > s) sc = -INFINITY; p_s[c * 256 + tid] = sc; mx = fmaxf(mx, sc); }
    for (int o = 1; o < 64; o <<= 1) mx = fmaxf(mx, __shfl_xor(mx, o));
    if (lane == 0) red_s[w] = mx;
    __syncthreads();
    mx = fmaxf(fmaxf(red_s[0], red_s[1]), fmaxf(red_s[2], red_s[3]));
    float sum = 0.f;
    for (int c = 0; c < cnt; ++c) { const float p = __expf(p_s[c * 256 + tid] - mx); p_s[c * 256 + tid] = p; sum += p; }
    for (int o = 1; o < 64; o <<= 1) sum += __shfl_xor(sum, o);
    if (lane == 0) red_s[4 + w] = sum;
    __syncthreads();
    const float l = red_s[4] + red_s[5] + red_s[6] + red_s[7];
    const int d = tid & 127, half = tid >> 7, nk = cnt * 256; float acc = 0.f;
    for (int i = half * (nk / 2); i < (half + 1) * (nk / 2); ++i) { const int pos = blk_s[i >> 8] * 256 + (i & 255); acc += p_s[i] * bf2f(Vb[((size_t)bh * S + pos) * HD + d]); }
    if (half == 1) acc_s[d] = acc;
    __syncthreads();
    if (half == 0) O[((size_t)(b * S + s)) * D + h * HD + d] = (bf16_t)f2bf_s((acc + acc_s[d]) / l);
}
__global__ __launch_bounds__(256) void conv_k(bf16_t* __restrict__ GB, const bf16_t* __restrict__ U, const float* __restrict__ cw) {
    const size_t idx = (size_t)blockIdx.x * 256 + threadIdx.x; const int row = (int)(idx >> 11), ch = (int)(idx & 2047), s = row & 2047;
    float y = cw[2 * D + ch] * bf2f(U[idx]);
    if (s >= 1) y += cw[1 * D + ch] * bf2f(U[idx - D]);
    if (s >= 2) y += cw[0 * D + ch] * bf2f(U[idx - 2 * D]);
    GB[idx] = (bf16_t)f2bf_s(bf2f(GB[idx]) * y);
}

extern "C" void kernel_launch(void* const* d_in, const int* in_sizes, int n_in, void* d_out, int out_size, void* d_ws, size_t ws_size, hipStream_t stream) {
    static int grid = 0;
    if (grid == 0) {
        if (n_in != 17 || in_sizes[0] != M * D || out_size != M * D || ws_size < WS_END) { fprintf(stderr, "kernel_launch: unexpected shapes (n_in %d out %d ws %zu)\n", n_in, out_size, ws_size); grid = -1; return; }
        int dev = 0, cus = 0, per_cu = 0;
        if (hipGetDevice(&dev) != hipSuccess || hipDeviceGetAttribute(&cus, hipDeviceAttributeMultiprocessorCount, dev) != hipSuccess) { grid = -1; return; }
        if (hipFuncSetAttribute((const void*)mk_fwd, hipFuncAttributeMaxDynamicSharedMemorySize, LDS_BYTES) != hipSuccess) { fprintf(stderr, "kernel_launch: hipFuncSetAttribute failed\n"); grid = -1; return; }
        if (hipOccupancyMaxActiveBlocksPerMultiprocessor(&per_cu, (const void*)mk_fwd, NWAVES * 64, LDS_BYTES) != hipSuccess || per_cu < 1) fprintf(stderr, "kernel_launch: occupancy query reports %d\n", per_cu);
        (void)hipGetLastError();
        grid = cus;
    }
    if (grid < 0) return;
    (void)hipMemsetAsync((char*)d_ws + WS_CTL, 0, CTL_ZERO_BYTES, stream);
    Args a{};
    for (int i = 0; i < 17; ++i) a.in[i] = (const float*)d_in[i];
    a.out = (float*)d_out; a.ws = (unsigned char*)d_ws;
    char* ws = (char*)d_ws; float* ctlf = (float*)(ws + WS_CTL);
#if MK_STAGE == 1
    a.ph_mask = 0x00f; a.li = 0;
    hipLaunchKernelGGL(mk_fwd, dim3(grid), dim3(NWAVES * 64), LDS_BYTES, stream, a);
    km_from_parts<<<32 * 2048 / 256, 256, 0, stream>>>(ctlf + CW_KPART, ctlf + CW_KM);
    attn_simple<<<NB * NH * S, 256, 0, stream>>>((const bf16_t*)(ws + WS_Q), (const bf16_t*)(ws + WS_K), (const bf16_t*)(ws + WS_V), ctlf + CW_KM, (bf16_t*)(ws + WS_O));
    conv_k<<<M * D / 256, 256, 0, stream>>>((bf16_t*)(ws + WS_GB), (const bf16_t*)(ws + WS_U), (const float*)d_in[8]);
    a.ph_mask = 0x3e0; a.li = 1;
    hipLaunchKernelGGL(mk_fwd, dim3(grid), dim3(NWAVES * 64), LDS_BYTES, stream, a);
#elif MK_STAGE == 3
    { const int P = MK_PROBE_PHASE; const int all = 0x7ff, lo = ((1 << (P + 1)) - 1) | (P >= 4 ? 0x400 : 0), hi = all & ~lo;
      a.ph_mask = lo; a.li = 0; hipLaunchKernelGGL(mk_fwd, dim3(grid), dim3(NWAVES * 64), LDS_BYTES, stream, a);
      if (MK_PROBE_REP) { a.ph_mask = 1 << P; a.li = 1; hipLaunchKernelGGL(mk_fwd, dim3(grid), dim3(NWAVES * 64), LDS_BYTES, stream, a); }
      if (hi) { a.ph_mask = hi; a.li = 2; hipLaunchKernelGGL(mk_fwd, dim3(grid), dim3(NWAVES * 64), LDS_BYTES, stream, a); } }
#else
    a.ph_mask = 0x7ff; a.li = 0;
    hipLaunchKernelGGL(mk_fwd, dim3(grid), dim3(NWAVES * 64), LDS_BYTES, stream, a);
#endif
}
```
